# Optimizing an MI355X kernel written in HIP

```python
import math
import jax
import jax.numpy as jnp
from jax import lax
import numpy as np

D_MODEL = 1024
BATCH = 2
SEQ = 8192
DEPTH = 2

GRID_W = 64
CTX_LEN = 256
Q_BLOCK = 128
WINDOW = 128
BAND = Q_BLOCK + 2 * WINDOW
N_BRANCH = 4
N_MOD = 6
EPS = 1e-6
ROPE_THETA = 10000.0
NEG_INF = -1e30
HEAD_DIM = 64
DIFF_HEADS = 4
DIFF_QK_DIM = 64
DIFF_V_DIM = 2 * DIFF_QK_DIM
MLA_HEADS = 8
MLA_Q_LORA = 256
MLA_KV_LORA = 256
MLA_NOPE_DIM = 64
MLA_ROPE_DIM = 32
MLA_V_DIM = 64
GQA_HEADS = 8
GQA_KV_HEADS = 2
SWA_HEADS = 8
SWA_KV_HEADS = 2
BRANCH_WIDTH = 512
D_FF = 2816
SPLIT_WIDTHS = (
    DIFF_HEADS * 2 * DIFF_QK_DIM,
    DIFF_HEADS * 2 * DIFF_QK_DIM,
    DIFF_HEADS * DIFF_V_DIM,
    MLA_Q_LORA,
    MLA_KV_LORA + MLA_ROPE_DIM,
    GQA_HEADS * HEAD_DIM, GQA_KV_HEADS * HEAD_DIM, GQA_KV_HEADS * HEAD_DIM,
    SWA_HEADS * HEAD_DIM, SWA_KV_HEADS * HEAD_DIM, SWA_KV_HEADS * HEAD_DIM,
    N_BRANCH * D_MODEL,
)
IN_WIDTH = sum(SPLIT_WIDTHS)
f32 = jnp.float32

kernel_name = 'hybrid_dit_prefix_block'


def rms_norm(x, gain=None):
    xf = x.astype(f32)
    y = xf * lax.rsqrt(jnp.mean(xf * xf, axis=-1, keepdims=True) + EPS)
    if gain is not None:
        y = y * gain.astype(f32)
    return y.astype(x.dtype)


def modulate(x, shift, scale):
    return rms_norm(x) * (1.0 + scale) + shift


def axial_rope_tables(row, col, rot_dim):
    axis_dim = rot_dim // 2
    inv = ROPE_THETA ** (-jnp.arange(0, axis_dim, 2, dtype=f32) / axis_dim)
    ang = jnp.concatenate([row[:, None].astype(f32) * inv, col[:, None].astype(f32) * inv], axis=-1)
    return jnp.cos(ang), jnp.sin(ang)


def rope_2d(x, cos, sin):
    xf = x.astype(f32).reshape(*x.shape[:-1], x.shape[-1] // 2, 2)
    x0, x1 = xf[..., 0], xf[..., 1]
    c, s = cos[:, None, :], sin[:, None, :]
    return jnp.stack([x0 * c - x1 * s, x0 * s + x1 * c], axis=-1).reshape(x.shape).astype(x.dtype)


def split_columns(z):
    out, start = [], 0
    for w in SPLIT_WIDTHS:
        out.append(z[..., start:start + w])
        start += w
    return out


def to_blocks(t):
    B, N = t.shape[:2]
    return jnp.moveaxis(t.reshape(B, N // Q_BLOCK, Q_BLOCK, *t.shape[2:]), 1, 0)


def from_blocks(t):
    nb, B = t.shape[:2]
    return jnp.moveaxis(t, 0, 1).reshape(B, nb * Q_BLOCK, *t.shape[3:])


def sweep_query_blocks(fn, q):
    return from_blocks(lax.map(fn, to_blocks(q)))


def window_band(x):
    B, N = x.shape[:2]
    xp = jnp.pad(x, [(0, 0), (WINDOW, WINDOW)] + [(0, 0)] * (x.ndim - 2))
    xb = xp.reshape(B, N // Q_BLOCK + 2, Q_BLOCK, *x.shape[2:])
    return jnp.concatenate([xb[:, :-2], xb[:, 1:-1], xb[:, 2:]], axis=2)


def gqa_attend(q, k, v, scale):
    s = jnp.einsum('bqhgd,bkhd->bhgqk', q, k).astype(f32) * scale
    p = jax.nn.softmax(s, axis=-1).astype(v.dtype)
    return jnp.einsum('bhgqk,bkhd->bqhgd', p, v)


def softmax_with_sink(s, sink):
    col = jnp.broadcast_to(sink.astype(f32)[None, :, :, None, None], s.shape[:-1] + (1,))
    return jax.nn.softmax(jnp.concatenate([col, s], axis=-1), axis=-1)[..., 1:]


def diff_attend(q, k, v, lam):
    s = jnp.einsum('bqhmd,bkhmd->bhmqk', q, k).astype(f32) * (DIFF_QK_DIM ** -0.5)
    p = jax.nn.softmax(s, axis=-1)
    pd = (p[:, :, 0] - lam * p[:, :, 1]).astype(v.dtype)
    return jnp.einsum('bhqk,bkhd->bqhd', pd, v)


def diff_attention(q, k, v, qc, kc, vc, lam_vec, subln, layer_idx, rope, with_ctx_out):
    H, d, dv = DIFF_HEADS, DIFF_QK_DIM, DIFF_V_DIM
    B, N, _ = q.shape
    L = kc.shape[1]
    lam_init = 0.8 - 0.6 * math.exp(-0.3 * layer_idx)
    lv = lam_vec.astype(f32)
    lam = jnp.exp(jnp.sum(lv[0] * lv[1])) - jnp.exp(jnp.sum(lv[2] * lv[3])) + lam_init
    qh = rope_2d(q.reshape(B, N, 2 * H, d), *rope).reshape(B, N, H, 2, d)
    kh = rope_2d(k.reshape(B, N, 2 * H, d), *rope).reshape(B, N, H, 2, d)
    kch = kc.reshape(B, L, H, 2, d)
    vch = vc.reshape(B, L, H, dv)
    k_all = jnp.concatenate([kch, kh], axis=1)
    v_all = jnp.concatenate([vch, v.reshape(B, N, H, dv)], axis=1)

    def finish(o):
        return (rms_norm(o, subln) * (1.0 - lam_init)).reshape(o.shape[0], o.shape[1], H * dv)

    out = finish(sweep_query_blocks(lambda qi: diff_attend(qi, k_all, v_all, lam), qh))
    out_c = None
    if with_ctx_out:
        out_c = finish(diff_attend(qc.reshape(B, L, H, 2, d), kch, vch, lam))
    return out, out_c


def mla_attention(dq, dkv, dqc, dkvc, q_norm, kv_norm, w_uq, w_ukv, rope, with_ctx_out):
    H, dn, dr, dv = MLA_HEADS, MLA_NOPE_DIM, MLA_ROPE_DIM, MLA_V_DIM
    scale = (dn + dr) ** -0.5

    def queries(t, rope):
        B, T, _ = t.shape
        q = (rms_norm(t, q_norm) @ w_uq).reshape(B, T, H, dn + dr)
        if rope is not None:
            q = jnp.concatenate([q[..., :dn], rope_2d(q[..., dn:], *rope)], axis=-1)
        return q[:, :, :, None, :]

    def keys_values(t, rope):
        B, T, _ = t.shape
        c_kv, k_rot = t[..., :MLA_KV_LORA], t[..., MLA_KV_LORA:]
        kv = (rms_norm(c_kv, kv_norm) @ w_ukv).reshape(B, T, H, dn + dv)
        k_rot = k_rot[:, :, None, :]
        if rope is not None:
            k_rot = rope_2d(k_rot, *rope)
        k = jnp.concatenate([kv[..., :dn], jnp.broadcast_to(k_rot, (B, T, H, dr))], axis=-1)
        return k, kv[..., dn:]

    B, N, _ = dq.shape
    L = dkvc.shape[1]
    k, v = keys_values(dkv, rope)
    kc, vc = keys_values(dkvc, None)
    k_all = jnp.concatenate([kc, k], axis=1)
    v_all = jnp.concatenate([vc, v], axis=1)
    out = sweep_query_blocks(lambda qi: gqa_attend(qi, k_all, v_all, scale), queries(dq, rope)).reshape(B, N, H * dv)
    out_c = None
    if with_ctx_out:
        out_c = gqa_attend(queries(dqc, None), kc, vc, scale).reshape(B, L, H * dv)
    return out, out_c


def grid_attention(q, k, v, qc, kc, vc, q_gain, k_gain, rope, with_ctx_out):
    H, Hkv, d = GQA_HEADS, GQA_KV_HEADS, HEAD_DIM
    G = H // Hkv
    scale = d ** -0.5
    B, N, _ = q.shape
    L = kc.shape[1]
    qh = rope_2d(rms_norm(q.reshape(B, N, H, d), q_gain), *rope).reshape(B, N, Hkv, G, d)
    kh = rope_2d(rms_norm(k.reshape(B, N, Hkv, d), k_gain), *rope)
    kch = rms_norm(kc.reshape(B, L, Hkv, d), k_gain)
    vch = vc.reshape(B, L, Hkv, d)
    k_all = jnp.concatenate([kch, kh], axis=1)
    v_all = jnp.concatenate([vch, v.reshape(B, N, Hkv, d)], axis=1)
    out = sweep_query_blocks(lambda qi: gqa_attend(qi, k_all, v_all, scale), qh).reshape(B, N, H * d)
    out_c = None
    if with_ctx_out:
        qch = rms_norm(qc.reshape(B, L, H, d), q_gain).reshape(B, L, Hkv, G, d)
        out_c = gqa_attend(qch, kch, vch, scale).reshape(B, L, H * d)
    return out, out_c


def window_attention(q, k, v, qc, kc, vc, sink, rope, with_ctx_out):
    H, Hkv, d = SWA_HEADS, SWA_KV_HEADS, HEAD_DIM
    G = H // Hkv
    scale = d ** -0.5
    B, N, _ = q.shape
    L = kc.shape[1]
    sink = sink.reshape(Hkv, G)
    qh = rope_2d(q.reshape(B, N, H, d), *rope).reshape(B, N, Hkv, G, d)
    kh = rope_2d(k.reshape(B, N, Hkv, d), *rope)
    kch = kc.reshape(B, L, Hkv, d)
    vch = vc.reshape(B, L, Hkv, d)
    kb = jnp.moveaxis(window_band(kh), 1, 0)
    vb = jnp.moveaxis(window_band(v.reshape(B, N, Hkv, d)), 1, 0)
    i_idx = jnp.arange(Q_BLOCK)[:, None]
    j_idx = jnp.arange(BAND)[None, :]

    def block(args):
        qi, ki, vi, n = args
        s_ctx = jnp.einsum('bqhgd,bkhd->bhgqk', qi, kch).astype(f32) * scale
        s_band = jnp.einsum('bqhgd,bkhd->bhgqk', qi, ki).astype(f32) * scale
        kpos = n * Q_BLOCK - WINDOW + j_idx
        valid = (jnp.abs(j_idx - WINDOW - i_idx) <= WINDOW) & (kpos >= 0) & (kpos < N)
        s_band = jnp.where(valid, s_band, NEG_INF)
        p = softmax_with_sink(jnp.concatenate([s_ctx, s_band], axis=-1), sink).astype(vi.dtype)
        return (jnp.einsum('bhgqk,bkhd->bqhgd', p[..., :L], vch)
                + jnp.einsum('bhgqk,bkhd->bqhgd', p[..., L:], vi))

    out = from_blocks(lax.map(block, (to_blocks(qh), kb, vb, jnp.arange(N // Q_BLOCK)))).reshape(B, N, H * d)
    out_c = None
    if with_ctx_out:
        s = jnp.einsum('bqhgd,bkhd->bhgqk', qc.reshape(B, L, Hkv, G, d), kch).astype(f32) * scale
        p = softmax_with_sink(s, sink).astype(vch.dtype)
        out_c = jnp.einsum('bhgqk,bkhd->bqhgd', p, vch).reshape(B, L, H * d)
    return out, out_c


def merge_branches(outs, g, w_branch, w_out):
    B, T, _ = g.shape
    y = jnp.einsum('btke,ked->btkd', jnp.stack(outs, axis=2), w_branch)
    gate = jax.nn.sigmoid(g.reshape(B, T, N_BRANCH, D_MODEL))
    return jnp.sum(gate * y, axis=2) @ w_out


def token_mixing(h, hc, lp, layer_idx, rope64, rope32, with_ctx_out):
    aq, ak, av, bq, bkv, cq, ck, cv, dq, dk, dv, g = split_columns(h @ lp['w_in'])
    aqc, akc, avc, bqc, bkvc, cqc, ckc, cvc, dqc, dkc, dvc, gc = split_columns(hc @ lp['w_in'])
    oa, oa_c = diff_attention(aq, ak, av, aqc, akc, avc, lp['diff_lambda'], lp['diff_subln'], layer_idx, rope64, with_ctx_out)
    ob, ob_c = mla_attention(bq, bkv, bqc, bkvc, lp['mla_q_norm'], lp['mla_kv_norm'], lp['mla_w_uq'], lp['mla_w_ukv'], rope32, with_ctx_out)
    oc, oc_c = grid_attention(cq, ck, cv, cqc, ckc, cvc, lp['gqa_q_norm'], lp['gqa_k_norm'], rope64, with_ctx_out)
    od, od_c = window_attention(dq, dk, dv, dqc, dkc, dvc, lp['swa_sink'], rope64, with_ctx_out)
    out = merge_branches([oa, ob, oc, od], g, lp['w_branch'], lp['w_out'])
    out_c = None
    if with_ctx_out:
        out_c = merge_branches([oa_c, ob_c, oc_c, od_c], gc, lp['w_branch'], lp['w_out'])
    return out, out_c


def conv_ffn(h, lp):
    u = h @ lp['ffn_w_up']
    T = u.shape[1]
    w = lp['ffn_conv_w']
    up = jnp.pad(u, ((0, 0), (1, 1), (0, 0)))
    u = up[:, :T] * w[0] + up[:, 1:T + 1] * w[1] + up[:, 2:] * w[2] + lp['ffn_conv_b']
    val, gate = jnp.split(u, 2, axis=-1)
    return (jax.nn.silu(gate) * val) @ lp['ffn_w_down']


def hybrid_layer(x, xc, c, c_ctx, lp, layer_idx, rope64, rope32, update_ctx):
    B = x.shape[0]
    mod = (jax.nn.silu(c) @ lp['w_mod'] + lp['b_mod']).reshape(B, 1, N_MOD, D_MODEL)
    mod_c = (jax.nn.silu(c_ctx) @ lp['w_mod'] + lp['b_mod']).reshape(1, 1, N_MOD, D_MODEL)
    h = modulate(x, mod[:, :, 0], mod[:, :, 1])
    hc = modulate(xc, mod_c[:, :, 0], mod_c[:, :, 1])
    mix, mix_c = token_mixing(h, hc, lp, layer_idx, rope64, rope32, update_ctx)
    x = x + mod[:, :, 2] * mix
    x = x + mod[:, :, 5] * conv_ffn(modulate(x, mod[:, :, 3], mod[:, :, 4]), lp)
    if update_ctx:
        xc = xc + mod_c[:, :, 2] * mix_c
        xc = xc + mod_c[:, :, 5] * conv_ffn(modulate(xc, mod_c[:, :, 3], mod_c[:, :, 4]), lp)
    return x, xc


def setup_inputs(seed: int = 0) -> dict:
    key = jax.random.key(seed)
    ks = jax.random.split(key, 23)

    def nrm(i, shape, scale):
        return scale * jax.random.normal(ks[i], shape, jnp.float32)

    def gain(i, shape):
        return 1.0 + nrm(i, shape, 0.02)

    return {
        'x': nrm(0, (BATCH, SEQ, D_MODEL), 1.0),
        'c': nrm(1, (BATCH, D_MODEL), 1.0),
        'ctx': nrm(2, (BATCH, CTX_LEN, D_MODEL), 1.0),
        'c_ctx': nrm(3, (D_MODEL,), 1.0),
        'w_mod': nrm(4, (DEPTH, D_MODEL, N_MOD * D_MODEL), 0.3 * D_MODEL ** -0.5),
        'b_mod': nrm(5, (DEPTH, N_MOD * D_MODEL), 0.02),
        'w_in': nrm(6, (DEPTH, D_MODEL, IN_WIDTH), D_MODEL ** -0.5),
        'diff_lambda': nrm(7, (DEPTH, 4, DIFF_QK_DIM), 0.1),
        'diff_subln': gain(8, (DEPTH, DIFF_V_DIM)),
        'mla_q_norm': gain(9, (DEPTH, MLA_Q_LORA)),
        'mla_kv_norm': gain(10, (DEPTH, MLA_KV_LORA)),
        'mla_w_uq': nrm(11, (DEPTH, MLA_Q_LORA, MLA_HEADS * (MLA_NOPE_DIM + MLA_ROPE_DIM)), MLA_Q_LORA ** -0.5),
        'mla_w_ukv': nrm(12, (DEPTH, MLA_KV_LORA, MLA_HEADS * (MLA_NOPE_DIM + MLA_V_DIM)), MLA_KV_LORA ** -0.5),
        'gqa_q_norm': gain(13, (DEPTH, HEAD_DIM)),
        'gqa_k_norm': gain(14, (DEPTH, HEAD_DIM)),
        'swa_sink': nrm(15, (DEPTH, SWA_HEADS), 0.5),
        'w_branch': nrm(16, (DEPTH, N_BRANCH, BRANCH_WIDTH, D_MODEL), BRANCH_WIDTH ** -0.5),
        'w_out': nrm(17, (DEPTH, D_MODEL, D_MODEL), D_MODEL ** -0.5),
        'ffn_w_up': nrm(18, (DEPTH, D_MODEL, 2 * D_FF), D_MODEL ** -0.5),
        'ffn_conv_w': nrm(19, (DEPTH, 3, 2 * D_FF), 0.5),
        'ffn_conv_b': nrm(20, (DEPTH, 2 * D_FF), 0.02),
        'ffn_w_down': nrm(21, (DEPTH, D_FF, D_MODEL), D_FF ** -0.5),
        'final_norm': gain(22, (D_MODEL,)),
    }


def reference(x, c, ctx, c_ctx, w_mod, b_mod, w_in, diff_lambda, diff_subln, mla_q_norm, mla_kv_norm,
              mla_w_uq, mla_w_ukv, gqa_q_norm, gqa_k_norm, swa_sink, w_branch, w_out, ffn_w_up,
              ffn_conv_w, ffn_conv_b, ffn_w_down, final_norm):
    N = x.shape[1]
    n_rows = N // GRID_W
    row = jnp.repeat(jnp.arange(n_rows, dtype=jnp.int32), GRID_W)
    col = jnp.tile(jnp.arange(GRID_W, dtype=jnp.int32), n_rows)
    rope64 = axial_rope_tables(row, col, HEAD_DIM)
    rope32 = axial_rope_tables(row, col, MLA_ROPE_DIM)
    xc = ctx
    for l in range(DEPTH):
        lp = dict(w_mod=w_mod[l], b_mod=b_mod[l], w_in=w_in[l], diff_lambda=diff_lambda[l],
                  diff_subln=diff_subln[l], mla_q_norm=mla_q_norm[l], mla_kv_norm=mla_kv_norm[l],
                  mla_w_uq=mla_w_uq[l], mla_w_ukv=mla_w_ukv[l], gqa_q_norm=gqa_q_norm[l],
                  gqa_k_norm=gqa_k_norm[l], swa_sink=swa_sink[l], w_branch=w_branch[l], w_out=w_out[l],
                  ffn_w_up=ffn_w_up[l], ffn_conv_w=ffn_conv_w[l], ffn_conv_b=ffn_conv_b[l],
                  ffn_w_down=ffn_w_down[l])
        x, xc = hybrid_layer(x, xc, c, c_ctx, lp, l, rope64, rope32, l < DEPTH - 1)
    return rms_norm(x, final_norm)
```

```cpp
#include <hip/hip_runtime.h>
#include <hip/hip_cooperative_groups.h>
#include <cstdio>
#include <cstdint>
namespace cg = cooperative_groups;

#ifndef PROBE
#define PROBE 0
#endif
#ifndef MK_COOP
#define MK_COOP 1
#endif

typedef unsigned short bf16_t;
typedef short bf16x8 __attribute__((ext_vector_type(8)));
typedef short s16x4 __attribute__((ext_vector_type(4)));
typedef float f32x16 __attribute__((ext_vector_type(16)));
typedef float f32x4 __attribute__((ext_vector_type(4)));
typedef __bf16 bf16x2_t __attribute__((ext_vector_type(2)));
#define DI __device__ __forceinline__
struct Ctx { int tid, bid; };
#define MFMA(a, b, c) __builtin_amdgcn_mfma_f32_32x32x16_bf16((a), (b), (c), 0, 0, 0)

constexpr int R = 16896, RB = 8448, NMAIN = 8192, NCTX = 256, DM = 1024;
constexpr int LDS_BYTES = 139264;
constexpr int NTH = 512;
constexpr int LDS_MISC = 131072;
constexpr float EPS = 1e-6f;
constexpr float LOG2E = 1.4426950408889634f;

constexpr size_t SZ_R512 = (size_t)R * 512 * 2, SZ_R128 = (size_t)R * 128 * 2, SZ_R768 = (size_t)R * 768 * 2, SZ_R1024 = (size_t)R * 1024 * 2;
constexpr size_t OFF_CTR = 0;
constexpr size_t OFF_MODP = 256;
constexpr size_t OFF_MODV = OFF_MODP + (size_t)2 * 8 * 3 * 6144 * 4;
constexpr size_t OFF_T64 = OFF_MODV + (size_t)2 * 3 * 6144 * 4;
constexpr size_t OFF_T32 = OFF_T64 + 128 * 16 * 8;
constexpr size_t OFF_XCTX = OFF_T32 + 128 * 8 * 8;
constexpr size_t OFF_WIN = OFF_XCTX + (size_t)512 * 1024 * 4;
constexpr size_t OFF_WUQ = OFF_WIN + (size_t)7936 * 1024 * 2;
constexpr size_t OFF_WUKV = OFF_WUQ + (size_t)768 * 256 * 2;
constexpr size_t OFF_WBR = OFF_WUKV + (size_t)1024 * 256 * 2;
constexpr size_t OFF_WOUT = OFF_WBR + (size_t)4 * 1024 * 512 * 2;
constexpr size_t OFF_H = OFF_WOUT + (size_t)1024 * 1024 * 2;
constexpr size_t OFF_BIG = OFF_H + SZ_R1024;
constexpr size_t OFF_QA = OFF_BIG;
constexpr size_t OFF_KA = OFF_QA + SZ_R512;
constexpr size_t OFF_VA = OFF_KA + SZ_R512;
constexpr size_t OFF_QC = OFF_VA + SZ_R512;
constexpr size_t OFF_KC = OFF_QC + SZ_R512;
constexpr size_t OFF_VC = OFF_KC + SZ_R128;
constexpr size_t OFF_QD = OFF_VC + SZ_R128;
constexpr size_t OFF_KD = OFF_QD + SZ_R512;
constexpr size_t OFF_VD = OFF_KD + SZ_R128;
constexpr size_t OFF_QB = OFF_VD + SZ_R128;
constexpr size_t OFF_KB = OFF_QB + SZ_R768;
constexpr size_t OFF_VB = OFF_KB + SZ_R768;
constexpr size_t OFF_OB = OFF_VB + SZ_R512;
constexpr size_t OFF_END_MIX = OFF_OB + SZ_R512;
constexpr size_t OFF_M = OFF_KA;
constexpr size_t OFF_WUP = OFF_BIG;
constexpr size_t OFF_WDN = OFF_WUP + (size_t)5632 * 1024 * 2;
constexpr size_t OFF_ACT = OFF_WDN + (size_t)1024 * 2816 * 2;
constexpr size_t OFF_END_FFN = OFF_ACT + (size_t)R * 2816 * 2;
constexpr size_t OFF_BAR = ((OFF_END_MIX > OFF_END_FFN ? OFF_END_MIX : OFF_END_FFN) + 4095) / 4096 * 4096;
constexpr size_t WS_NEED = OFF_BAR + 16384;

struct Params {
  const float *x, *c, *ctx, *c_ctx, *w_mod, *b_mod, *w_in, *diff_lambda, *diff_subln, *mla_q_norm, *mla_kv_norm, *mla_w_uq, *mla_w_ukv,
      *gqa_q_norm, *gqa_k_norm, *swa_sink, *w_branch, *w_out, *ffn_w_up, *ffn_conv_w, *ffn_conv_b, *ffn_w_down, *final_norm;
  float* out;
  char* ws;
};

DI unsigned pack2(float a, float b) { bf16x2_t v; v.x = (__bf16)a; v.y = (__bf16)b; return __builtin_bit_cast(unsigned, v); }
DI float bf2f(bf16_t v) { return __uint_as_float(((unsigned)v) << 16); }
DI float swap_max(float x) { auto r = __builtin_amdgcn_permlane32_swap(__float_as_uint(x), __float_as_uint(x), false, false); return fmaxf(__uint_as_float(r[0]), __uint_as_float(r[1])); }
DI float swap_sum(float x) { auto r = __builtin_amdgcn_permlane32_swap(__float_as_uint(x), __float_as_uint(x), false, false); return __uint_as_float(r[0]) + __uint_as_float(r[1]); }
DI float wave_sum(float v) { for (int o = 32; o > 0; o >>= 1) v += __shfl_xor(v, o); return v; }
DI float silu_f(float v) { return v / (1.f + __expf(-v)); }
DI float sigmoid_f(float v) { return 1.f / (1.f + __expf(-v)); }
DI const float* x_row_src(const Params& p, bool from_inputs, int r) {
  int b = r >= RB ? 1 : 0, pp = r - b * RB;
  if (pp < NCTX) return (from_inputs ? p.ctx : (const float*)(p.ws + OFF_XCTX)) + (size_t)(b * NCTX + pp) * DM;
  return (from_inputs ? p.x : (const float*)p.out) + (size_t)(b * NMAIN + pp - NCTX) * DM;
}
DI float* x_row_dst(const Params& p, int r) {
  int b = r >= RB ? 1 : 0, pp = r - b * RB;
  if (pp < NCTX) return (float*)(p.ws + OFF_XCTX) + (size_t)(b * NCTX + pp) * DM;
  return p.out + (size_t)(b * NMAIN + pp - NCTX) * DM;
}
DI int variant_of(int r) { int b = r >= RB ? 1 : 0, pp = r - b * RB; return pp < NCTX ? 2 : b; }
DI int tt_of(int layer, int idx) { return layer == 0 ? idx : (idx >> 5) * 33 + 1 + (idx & 31); }

#define XCD_ITEMS_BEGIN(NT_, NF_) { const int nbx_ = (int)gridDim.x >> 3, xx_ = cx.bid & 7, nown_ = (NT_) >> 3, town_ = nown_ * (NF_); \
  const int nlo_ = ((NT_) - 8 * nown_) * (NF_), text_ = (nlo_ > xx_) ? (nlo_ - xx_ + 7) >> 3 : 0;     \
  for (int q_ = cx.bid >> 3; q_ < town_ + text_; q_ += nbx_) { int ft, tti; \
    if (q_ < town_) { const int g_ = q_ / (8 * (NF_)), r_ = q_ - g_ * 8 * (NF_), gs_ = min(8, nown_ - 8 * g_); \
      ft = r_ / gs_; tti = xx_ + 8 * (8 * g_ + (r_ - ft * gs_)); } \
    else { const int e_ = xx_ + 8 * (q_ - town_); tti = 8 * nown_ + e_ / (NF_); ft = e_ - (tti - 8 * nown_) * (NF_); }
#define XCD_ITEMS_END } }
template <int MF, bool CLAMP = false>
DI void gemm_core(const Ctx cx, const bf16_t* __restrict__ W, int ldw, const bf16_t* __restrict__ X, int ldx, int rbase, int rlo, int rhi, int K,
                  f32x16 (&acc)[MF][2], char* lds) {
  constexpr int AB = 64 * MF * 128, SS = AB + 32768;
  const int tid = cx.tid, lane = tid & 63, wave = tid >> 6, wm = wave >> 2, wn = wave & 3, l31 = lane & 31, h = lane >> 5;
  const int srow = tid >> 3, sch = (tid & 7) ^ ((srow >> 1) & 7);
  const bf16_t* wp = W + (size_t)srow * ldw + sch * 8;
  const bf16_t* xp[4];
  if (CLAMP) {
#pragma unroll
    for (int c = 0; c < 4; ++c) { int xr = min(max(rbase + srow + 64 * c, rlo), rhi); xp[c] = X + (size_t)xr * ldx + sch * 8; }
  } else {
    xp[0] = X + (size_t)(rbase + srow) * ldx + sch * 8;
  }
  char* lw = lds + tid * 16;
  const int swz = (l31 >> 1) & 7;
  const int offA = (wm * 32 * MF + l31) * 128, offB = AB + (wn * 64 + l31) * 128;
  const int nk = K >> 6;
#define GSTAGE(buf_, ko_) do { char* d_ = lw + (buf_) * SS; \
    _Pragma("unroll") for (int c = 0; c < MF; ++c) \
      __builtin_amdgcn_global_load_lds((const unsigned*)(wp + (size_t)(64 * c) * ldw + (ko_)), (__attribute__((address_space(3))) unsigned*)(d_ + 8192 * c), 16, 0, 0); \
    _Pragma("unroll") for (int c = 0; c < 4; ++c) \
      __builtin_amdgcn_global_load_lds((const unsigned*)((CLAMP ? xp[c] : xp[0] + (size_t)(64 * c) * ldx) + (ko_)), (__attribute__((address_space(3))) unsigned*)(d_ + AB + 8192 * c), 16, 0, 0); } while (0)
  GSTAGE(0, 0);
  __syncthreads();
  int buf = 0;
  for (int kt = 0; kt < nk; ++kt) {
    if (kt + 1 < nk) GSTAGE(buf ^ 1, (kt + 1) * 64);
    const char* base = lds + buf * SS;
    bf16x8 a[2][MF], b[2][2];
    {
      const int co = (h ^ swz) << 4;
#pragma unroll
      for (int fi = 0; fi < MF; ++fi) a[0][fi] = *(const bf16x8*)(base + offA + fi * 4096 + co);
      b[0][0] = *(const bf16x8*)(base + offB + co); b[0][1] = *(const bf16x8*)(base + offB + 4096 + co);
    }
#pragma unroll
    for (int s = 0; s < 4; ++s) {
      if (s < 3) {
        const int co = ((2 * (s + 1) + h) ^ swz) << 4;
#pragma unroll
        for (int fi = 0; fi < MF; ++fi) a[(s + 1) & 1][fi] = *(const bf16x8*)(base + offA + fi * 4096 + co);
        b[(s + 1) & 1][0] = *(const bf16x8*)(base + offB + co); b[(s + 1) & 1][1] = *(const bf16x8*)(base + offB + 4096 + co);
      }
#pragma unroll
      for (int fi = 0; fi < MF; ++fi) { acc[fi][0] = MFMA(a[s & 1][fi], b[s & 1][0], acc[fi][0]); acc[fi][1] = MFMA(a[s & 1][fi], b[s & 1][1], acc[fi][1]); }
    }
    __syncthreads();
    buf ^= 1;
  }
#undef GSTAGE
}
template <int MF>
DI void zero_acc(f32x16 (&acc)[MF][2]) {
#pragma unroll
  for (int a = 0; a < MF; ++a)
#pragma unroll
    for (int b = 0; b < 2; ++b)
#pragma unroll
      for (int i = 0; i < 16; ++i) acc[a][b][i] = 0.f;
}

DI int rowmap_win(int n) {
  if (n < 1536) return n;
  if (n < 1792) return 3072 + (n - 1536);
  if (n < 2048) return 3328 + (n - 1792);
  if (n < 2080) return 3584 + (n - 2048);
  if (n < 2592) return 1536 + (n - 2080);
  if (n < 2720) return 2048 + (n - 2592);
  if (n < 2848) return 2176 + (n - 2720);
  if (n < 3360) return 2304 + (n - 2848);
  if (n < 3488) return 2816 + (n - 3360);
  if (n < 3616) return 2944 + (n - 3488);
  return 3840 + (n - 3616);
}
DI int rowmap(int mode, int n) {
  switch (mode) {
    case 1: return rowmap_win(n);
    case 2: { int hd = n / 96, d = n - hd * 96; return d < 64 ? hd * 64 + d : 512 + hd * 32 + (d - 64); }
    case 3: { int hd = n >> 7, d = n & 127; return d < 64 ? hd * 64 + d : 512 + hd * 64 + (d - 64); }
    case 4: { if (n < 2816) return 128 * (n >> 6) + (n & 63); int f = n - 2816; return 128 * (f >> 6) + 64 + (f & 63); }
    default: return n;
  }
}
DI void convert_tile(const Ctx cx, const float* __restrict__ src, int N, bf16_t* __restrict__ dst, int ldd, int mode, const float* __restrict__ kscale, int kt, int nt, char* lds) {
  float* lf = (float*)lds;
  const int tid = cx.tid, k0 = kt * 64, n0 = nt * 64;
#pragma unroll
  for (int i = 0; i < 8; ++i) { int e = tid + 512 * i, kk = e >> 6, nn = e & 63; lf[kk * 65 + nn] = (n0 + nn < N) ? src[(size_t)(k0 + kk) * N + n0 + nn] : 0.f; }
  __syncthreads();
  const int nn = tid >> 3, kc = tid & 7;
  float v[8];
#pragma unroll
  for (int j = 0; j < 8; ++j) { v[j] = lf[(kc * 8 + j) * 65 + nn]; if (kscale) v[j] *= kscale[k0 + kc * 8 + j]; }
  uint4 o; o.x = pack2(v[0], v[1]); o.y = pack2(v[2], v[3]); o.z = pack2(v[4], v[5]); o.w = pack2(v[6], v[7]);
  if (n0 + nn < N) *(uint4*)(dst + (size_t)rowmap(mode, n0 + nn) * ldd + k0 + kc * 8) = o;
  __syncthreads();
}
DI void convert_mix(const Ctx cx, const Params& p, int l, char* lds) {
  const int NI = 1936 + 48 + 64 + 512 + 256 + 224;
  for (int it = cx.bid; it < NI; it += gridDim.x) {
    if (it < 1936) { convert_tile(cx, p.w_in + (size_t)l * 1024 * 7712, 7712, (bf16_t*)(p.ws + OFF_WIN), 1024, 1, nullptr, it / 121, it % 121, lds); continue; }
    int i = it - 1936;
    if (i < 48) { convert_tile(cx, p.mla_w_uq + (size_t)l * 256 * 768, 768, (bf16_t*)(p.ws + OFF_WUQ), 256, 2, p.mla_q_norm + l * 256, i / 12, i % 12, lds); continue; }
    i -= 48;
    if (i < 64) { convert_tile(cx, p.mla_w_ukv + (size_t)l * 256 * 1024, 1024, (bf16_t*)(p.ws + OFF_WUKV), 256, 3, p.mla_kv_norm + l * 256, i / 16, i % 16, lds); continue; }
    i -= 64;
    if (i < 512) { int k = i >> 7, j = i & 127; convert_tile(cx, p.w_branch + ((size_t)l * 4 + k) * 512 * 1024, 1024, (bf16_t*)(p.ws + OFF_WBR) + (size_t)k * 1024 * 512, 512, 0, nullptr, j / 16, j % 16, lds); continue; }
    i -= 512;
    if (i < 256) { convert_tile(cx, p.w_out + (size_t)l * 1024 * 1024, 1024, (bf16_t*)(p.ws + OFF_WOUT), 1024, 0, nullptr, i / 16, i % 16, lds); continue; }
    i -= 256;
    *(unsigned*)((bf16_t*)(p.ws + OFF_WIN) + (size_t)(3616 + i) * 1024 + cx.tid * 2) = 0u;
  }
}
DI void convert_ffn(const Ctx cx, const Params& p, int l, char* lds) {
  const int NI = 1408 + 704;
  for (int it = cx.bid; it < NI; it += gridDim.x) {
    if (it < 1408) { convert_tile(cx, p.ffn_w_up + (size_t)l * 1024 * 5632, 5632, (bf16_t*)(p.ws + OFF_WUP), 1024, 4, nullptr, it / 88, it % 88, lds); continue; }
    int i = it - 1408;
    convert_tile(cx, p.ffn_w_down + (size_t)l * 2816 * 1024, 1024, (bf16_t*)(p.ws + OFF_WDN), 2816, 0, nullptr, i / 16, i % 16, lds);
  }
}

DI void sincos_d(double ang, float& co, float& si) {
  const double TWO_PI = 6.283185307179586476925286766559;
  double k = rint(ang / TWO_PI);
  double r = ang - k * TWO_PI;
  double r2 = r * r, ts = r, tc = 1.0, s = r, c = 1.0;
  for (int i = 1; i <= 16; ++i) {
    tc *= -r2 / (double)((2 * i - 1) * (2 * i));
    ts *= -r2 / (double)((2 * i) * (2 * i + 1));
    c += tc; s += ts;
  }
  co = (float)c; si = (float)s;
}
DI void prep0(const Ctx cx, const Params& p, char* lds) {
  const int tid = cx.tid;
  if (cx.bid == 0 && tid < 64) ((int*)(p.ws + OFF_CTR))[tid] = 0;
  for (int idx = cx.bid * NTH + tid; idx < 128 * 16 + 128 * 8; idx += gridDim.x * NTH) {
    if (idx < 2048) {
      int pos = idx >> 4, i = idx & 15;
      double inv = 1.0; for (int j = 0; j < i; ++j) inv *= 0.5623413251903491;
      float co, si; sincos_d((double)pos * inv, co, si);
      ((float2*)(p.ws + OFF_T64))[idx] = make_float2(co, si);
    } else {
      int e = idx - 2048, pos = e >> 3, i = e & 7;
      double inv = 1.0; for (int j = 0; j < i; ++j) inv *= 0.31622776601683794;
      float co, si; sincos_d((double)pos * inv, co, si);
      ((float2*)(p.ws + OFF_T32))[e] = make_float2(co, si);
    }
  }
  float* sl = (float*)lds;
  for (int it = cx.bid; it < 192; it += gridDim.x) {
    int l = it / 96, r = it % 96, cc = r >> 3, kc = r & 7;
    __syncthreads();
    if (tid < 128) {
      int k = kc * 128 + tid;
      sl[tid] = silu_f(p.c[k]); sl[128 + tid] = silu_f(p.c[1024 + k]); sl[256 + tid] = silu_f(p.c_ctx[k]);
    }
    __syncthreads();
    const int col = cc * NTH + tid;
    const float* w = p.w_mod + ((size_t)l * 1024 + kc * 128) * 6144 + col;
    float a0 = 0.f, a1 = 0.f, a2 = 0.f;
#pragma unroll 8
    for (int k = 0; k < 128; ++k) { float wv = w[(size_t)k * 6144]; a0 += sl[k] * wv; a1 += sl[128 + k] * wv; a2 += sl[256 + k] * wv; }
    float* mp = (float*)(p.ws + OFF_MODP) + (size_t)((l * 8 + kc) * 3) * 6144 + col;
    mp[0] = a0; mp[6144] = a1; mp[2 * 6144] = a2;
  }
  __syncthreads();
  convert_mix(cx, p, 0, lds);
}

DI float mod_from_partials(const Params& p, int l, int v, int idx) {
  const float* mp = (const float*)(p.ws + OFF_MODP) + (size_t)(l * 8 * 3 + v) * 6144 + idx;
  float s = p.b_mod[l * 6144 + idx];
#pragma unroll
  for (int k = 0; k < 8; ++k) s += mp[(size_t)k * 3 * 6144];
  return s;
}
DI void norm_phase(const Ctx cx, const Params& p, int l, int which, bool from_inputs, bool partials, bool skip_ctx, char* lds) {
  const int tid = cx.tid, lane = tid & 63, wave = tid >> 6;
  float* ms = (float*)lds;
  const int sh = which ? 3 : 0;
  for (int e = tid; e < 6144; e += NTH) {
    int v = e >> 11, r = e & 2047, idx = (sh + (r >> 10)) * 1024 + (r & 1023);
    ms[e] = partials ? mod_from_partials(p, l, v, idx) : ((const float*)(p.ws + OFF_MODV))[(size_t)(l * 3 + v) * 6144 + idx];
  }
  if (partials) {
    for (int e = cx.bid * NTH + tid; e < 2 * 3 * 6144; e += gridDim.x * NTH) {
      int ll = e / (3 * 6144), r = e % (3 * 6144), v = r / 6144, idx = r % 6144;
      ((float*)(p.ws + OFF_MODV))[e] = mod_from_partials(p, ll, v, idx);
    }
  }
  __syncthreads();
  bf16_t* H = (bf16_t*)(p.ws + OFF_H);
  const int rstride = (int)gridDim.x * 8;
  for (int r0 = cx.bid * 8 + wave; r0 < R; r0 += 2 * rstride) {
    const int r1 = r0 + rstride;
    const int v0 = variant_of(r0), v1 = r1 < R ? variant_of(r1) : 2;
    const bool on0 = !(skip_ctx && v0 == 2), on1 = (r1 < R) && !(skip_ctx && v1 == 2);
    float4 xa[4], xb[4];
    if (on0) { const float* xr = x_row_src(p, from_inputs, r0);
#pragma unroll
      for (int i = 0; i < 4; ++i) xa[i] = *(const float4*)(xr + i * 256 + lane * 4); }
    if (on1) { const float* xr = x_row_src(p, from_inputs, r1);
#pragma unroll
      for (int i = 0; i < 4; ++i) xb[i] = *(const float4*)(xr + i * 256 + lane * 4); }
#pragma unroll
    for (int rr = 0; rr < 2; ++rr) {
      if (!(rr == 0 ? on0 : on1)) continue;
      const int r = rr == 0 ? r0 : r1, v = rr == 0 ? v0 : v1;
      float4 xv[4]; float ss = 0.f;
#pragma unroll
      for (int i = 0; i < 4; ++i) { xv[i] = rr == 0 ? xa[i] : xb[i]; ss += xv[i].x * xv[i].x + xv[i].y * xv[i].y + xv[i].z * xv[i].z + xv[i].w * xv[i].w; }
      ss = wave_sum(ss);
      const float rstd = rsqrtf(ss * (1.f / 1024.f) + EPS);
      const float* shp = ms + v * 2048; const float* scp = shp + 1024;
#pragma unroll
      for (int i = 0; i < 4; ++i) {
        int c = i * 256 + lane * 4;
        float y0 = xv[i].x * rstd * (1.f + scp[c]) + shp[c], y1 = xv[i].y * rstd * (1.f + scp[c + 1]) + shp[c + 1];
        float y2 = xv[i].z * rstd * (1.f + scp[c + 2]) + shp[c + 2], y3 = xv[i].w * rstd * (1.f + scp[c + 3]) + shp[c + 3];
        uint2 o; o.x = pack2(y0, y1); o.y = pack2(y2, y3);
        *(uint2*)(H + (size_t)r * 1024 + c) = o;
      }
    }
  }
  __syncthreads();
}

struct TokInfo { int r, b, pp, trow, tcol; bool is_main; };
DI TokInfo tok_info(int r) { TokInfo t; t.r = r; t.b = r >= RB ? 1 : 0; t.pp = r - t.b * RB; t.is_main = t.pp >= NCTX; int n = t.pp - NCTX; t.trow = (n >> 6) & 127; t.tcol = n & 63; return t; }

DI void epi_qk64(const f32x16& a0, const f32x16& a1, const TokInfo& t, int h, const float* __restrict__ gain, bool rope, float scale,
                 bf16_t* __restrict__ dst, int ld, int col, const float2* __restrict__ T64) {
  float v[2][16];
#pragma unroll
  for (int i = 0; i < 16; ++i) { v[0][i] = a0[i]; v[1][i] = a1[i]; }
  if (gain) {
    float ss = 0.f;
#pragma unroll
    for (int i = 0; i < 16; ++i) ss += v[0][i] * v[0][i] + v[1][i] * v[1][i];
    ss = swap_sum(ss);
    const float rstd = rsqrtf(ss * (1.f / 64.f) + EPS);
#pragma unroll
    for (int fi = 0; fi < 2; ++fi)
#pragma unroll
      for (int i = 0; i < 16; ++i) v[fi][i] *= rstd * gain[fi * 32 + 8 * (i >> 2) + 4 * h + (i & 3)];
  }
  if (rope && t.is_main) {
#pragma unroll
    for (int fi = 0; fi < 2; ++fi) {
      const float2* tb = T64 + (fi == 0 ? t.trow : t.tcol) * 16;
#pragma unroll
      for (int g = 0; g < 4; ++g)
#pragma unroll
        for (int jj = 0; jj < 2; ++jj) {
          float2 cs = tb[4 * g + 2 * h + jj];
          float x0 = v[fi][4 * g + 2 * jj], x1 = v[fi][4 * g + 2 * jj + 1];
          v[fi][4 * g + 2 * jj] = x0 * cs.x - x1 * cs.y;
          v[fi][4 * g + 2 * jj + 1] = x0 * cs.y + x1 * cs.x;
        }
    }
  }
  bf16_t* d = dst + (size_t)t.r * ld + col + 4 * h;
#pragma unroll
  for (int fi = 0; fi < 2; ++fi)
#pragma unroll
    for (int g = 0; g < 4; ++g) {
      uint2 o; o.x = pack2(v[fi][4 * g] * scale, v[fi][4 * g + 1] * scale); o.y = pack2(v[fi][4 * g + 2] * scale, v[fi][4 * g + 3] * scale);
      *(uint2*)(d + fi * 32 + 8 * g) = o;
    }
}
DI void epi_vt(const f32x16& a0, const f32x16& a1, const TokInfo& t, int h, bf16_t* __restrict__ VT, int nh, int head, int dv, int d0, float scale) {
  bf16_t* d = VT + ((size_t)(t.b * nh + head) * dv + d0 + 4 * h) * RB + t.pp;
#pragma unroll
  for (int i = 0; i < 16; ++i) {
    int f = 8 * (i >> 2) + (i & 3);
    d[(size_t)f * RB] = (bf16_t)(pack2(a0[i] * scale, 0.f) & 0xffff);
    d[(size_t)(32 + f) * RB] = (bf16_t)(pack2(a1[i] * scale, 0.f) & 0xffff);
  }
}
DI void epi_plain(const f32x16& a0, const f32x16& a1, const TokInfo& t, int h, bf16_t* __restrict__ dst, int ld, int col, float scale) {
  bf16_t* d = dst + (size_t)t.r * ld + col + 4 * h;
#pragma unroll
  for (int g = 0; g < 4; ++g) {
    uint2 o; o.x = pack2(a0[4 * g] * scale, a0[4 * g + 1] * scale); o.y = pack2(a0[4 * g + 2] * scale, a0[4 * g + 3] * scale);
    *(uint2*)(d + 8 * g) = o;
    uint2 q; q.x = pack2(a1[4 * g] * scale, a1[4 * g + 1] * scale); q.y = pack2(a1[4 * g + 2] * scale, a1[4 * g + 3] * scale);
    *(uint2*)(d + 32 + 8 * g) = q;
  }
}

DI void gemm_in_phase(const Ctx cx, const Params& p, int l, char* lds, int skip_epi = 0) {
  const int tid = cx.tid, lane = tid & 63, wave = tid >> 6, wm = wave >> 2, wn = wave & 3, l31 = lane & 31, h = lane >> 5;
  const bf16_t* W = (const bf16_t*)(p.ws + OFF_WIN);
  const bf16_t* H = (const bf16_t*)(p.ws + OFF_H);
  const float2* T64 = (const float2*)(p.ws + OFF_T64);
  const float2* T32 = (const float2*)(p.ws + OFF_T32);
  const float qs64 = 0.125f * LOG2E;
  XCD_ITEMS_BEGIN(66, 15)
    const int tt = tti;
    f32x16 acc[4][2]; zero_acc<4>(acc);
    gemm_core<4>(cx, W + (size_t)ft * 256 * 1024, 1024, H, 1024, tt * 256, 0, R - 1, 1024, acc, lds);
    if (skip_epi) { if (acc[0][0][0] == 12345.678f && acc[1][1][3] == 1.f && acc[2][0][5] == 2.f && acc[3][1][7] == 3.f) ((float*)(p.ws + OFF_CTR))[40] = 1.f; continue; }
#pragma unroll
    for (int gi = 0; gi < 2; ++gi) {
    const int fb = ft * 256 + wm * 128 + gi * 64;
#pragma unroll
    for (int ti = 0; ti < 2; ++ti) {
      const TokInfo t = tok_info(tt * 256 + wn * 64 + ti * 32 + l31);
      const f32x16& a0 = acc[2 * gi][ti]; const f32x16& a1 = acc[2 * gi + 1][ti];
      if (fb < 512) epi_qk64(a0, a1, t, h, nullptr, true, qs64, (bf16_t*)(p.ws + OFF_QA), 512, fb, T64);
      else if (fb < 1024) epi_qk64(a0, a1, t, h, nullptr, true, 1.f, (bf16_t*)(p.ws + OFF_KA), 512, fb - 512, T64);
      else if (fb < 1536) epi_vt(a0, a1, t, h, (bf16_t*)(p.ws + OFF_VA), 4, (fb - 1024) >> 7, 128, (fb - 1024) & 127, 1.f);
      else if (fb < 2048) epi_qk64(a0, a1, t, h, p.gqa_q_norm + l * 64, true, qs64, (bf16_t*)(p.ws + OFF_QC), 512, fb - 1536, T64);
      else if (fb < 2176) epi_qk64(a0, a1, t, h, p.gqa_k_norm + l * 64, true, 1.f, (bf16_t*)(p.ws + OFF_KC), 128, fb - 2048, T64);
      else if (fb < 2304) epi_vt(a0, a1, t, h, (bf16_t*)(p.ws + OFF_VC), 2, (fb - 2176) >> 6, 64, 0, 1.f);
      else if (fb < 2816) epi_qk64(a0, a1, t, h, nullptr, true, qs64, (bf16_t*)(p.ws + OFF_QD), 512, fb - 2304, T64);
      else if (fb < 2944) epi_qk64(a0, a1, t, h, nullptr, true, 1.f, (bf16_t*)(p.ws + OFF_KD), 128, fb - 2816, T64);
      else if (fb < 3072) epi_vt(a0, a1, t, h, (bf16_t*)(p.ws + OFF_VD), 2, (fb - 2944) >> 6, 64, 0, 1.f);
      else if (fb < 3328) epi_plain(a0, a1, t, h, (bf16_t*)(p.ws + OFF_OB), 256, fb - 3072, 1.f);
      else if (fb < 3584) epi_plain(a0, a1, t, h, (bf16_t*)(p.ws + OFF_OB) + (size_t)R * 256, 256, fb - 3328, 1.f);
      else if (fb < 3648) {
        float v[16];
#pragma unroll
        for (int i = 0; i < 16; ++i) v[i] = a0[i];
        if (t.is_main) {
#pragma unroll
          for (int g = 0; g < 4; ++g)
#pragma unroll
            for (int jj = 0; jj < 2; ++jj) {
              float2 cs = g < 2 ? T32[t.trow * 8 + 4 * g + 2 * h + jj] : T32[t.tcol * 8 + 4 * (g - 2) + 2 * h + jj];
              float x0 = v[4 * g + 2 * jj], x1 = v[4 * g + 2 * jj + 1];
              v[4 * g + 2 * jj] = x0 * cs.x - x1 * cs.y; v[4 * g + 2 * jj + 1] = x0 * cs.y + x1 * cs.x;
            }
        }
        bf16_t* d = (bf16_t*)(p.ws + OFF_KB) + (size_t)t.r * 768 + 64 + 4 * h;
#pragma unroll
        for (int g = 0; g < 4; ++g) {
          uint2 o; o.x = pack2(v[4 * g], v[4 * g + 1]); o.y = pack2(v[4 * g + 2], v[4 * g + 3]);
#pragma unroll
          for (int hd = 0; hd < 8; ++hd) *(uint2*)(d + hd * 96 + 8 * g) = o;
        }
      }
    }
    }
  XCD_ITEMS_END
}

DI void gemm_mla_phase(const Ctx cx, const Params& p, char* lds) {
  const int tid = cx.tid, lane = tid & 63, wave = tid >> 6, wm = wave >> 2, wn = wave & 3, l31 = lane & 31, h = lane >> 5;
  const float2* T32 = (const float2*)(p.ws + OFF_T32);
  float* rs = (float*)(lds + LDS_MISC);
  const float qs96 = 0.10206207261596577f * LOG2E;
  XCD_ITEMS_BEGIN(66, 7)
    const int tt = tti, fti = ft;
    const bool isq = fti < 3;
    const int ft2 = isq ? fti : fti - 3;
    const bf16_t* X = (const bf16_t*)(p.ws + OFF_OB) + (isq ? 0 : (size_t)R * 256);
    const bf16_t* W = (const bf16_t*)(p.ws + (isq ? OFF_WUQ : OFF_WUKV)) + (size_t)ft2 * 256 * 256;
    {
      const int row = tid >> 1, half = tid & 1;
      const bf16_t* xr = X + (size_t)(tt * 256 + row) * 256 + half * 128;
      float ss = 0.f;
#pragma unroll
      for (int i = 0; i < 16; ++i) {
        uint4 u = *(const uint4*)(xr + i * 8);
        unsigned w4[4] = {u.x, u.y, u.z, u.w};
#pragma unroll
        for (int j = 0; j < 4; ++j) { float a = __uint_as_float(w4[j] << 16), b = __uint_as_float(w4[j] & 0xffff0000u); ss += a * a + b * b; }
      }
      ss += __shfl_xor(ss, 1);
      if (half == 0) rs[row] = rsqrtf(ss * (1.f / 256.f) + EPS);
    }
    f32x16 acc[4][2]; zero_acc<4>(acc);
    gemm_core<4>(cx, W, 256, X, 256, tt * 256, 0, R - 1, 256, acc, lds);
#pragma unroll
    for (int gi = 0; gi < 2; ++gi) {
    const int fb = ft2 * 256 + wm * 128 + gi * 64;
#pragma unroll
    for (int ti = 0; ti < 2; ++ti) {
      const int tl = wn * 64 + ti * 32 + l31;
      const TokInfo t = tok_info(tt * 256 + tl);
      const float rstd = rs[tl];
      const f32x16& a0 = acc[2 * gi][ti]; const f32x16& a1 = acc[2 * gi + 1][ti];
      if (isq) {
        if (fb < 512) epi_plain(a0, a1, t, h, (bf16_t*)(p.ws + OFF_QB), 768, (fb >> 6) * 96, rstd * qs96);
        else {
#pragma unroll
          for (int fi = 0; fi < 2; ++fi) {
            const int head = ((fb - 512) >> 5) + fi;
            float v[16];
#pragma unroll
            for (int i = 0; i < 16; ++i) v[i] = (fi == 0 ? a0[i] : a1[i]) * (rstd * qs96);
            if (t.is_main) {
#pragma unroll
              for (int g = 0; g < 4; ++g)
#pragma unroll
                for (int jj = 0; jj < 2; ++jj) {
                  float2 cs = g < 2 ? T32[t.trow * 8 + 4 * g + 2 * h + jj] : T32[t.tcol * 8 + 4 * (g - 2) + 2 * h + jj];
                  float x0 = v[4 * g + 2 * jj], x1 = v[4 * g + 2 * jj + 1];
                  v[4 * g + 2 * jj] = x0 * cs.x - x1 * cs.y; v[4 * g + 2 * jj + 1] = x0 * cs.y + x1 * cs.x;
                }
            }
            bf16_t* d = (bf16_t*)(p.ws + OFF_QB) + (size_t)t.r * 768 + head * 96 + 64 + 4 * h;
#pragma unroll
            for (int g = 0; g < 4; ++g) { uint2 o; o.x = pack2(v[4 * g], v[4 * g + 1]); o.y = pack2(v[4 * g + 2], v[4 * g + 3]); *(uint2*)(d + 8 * g) = o; }
          }
        }
      } else {
        if (fb < 512) epi_plain(a0, a1, t, h, (bf16_t*)(p.ws + OFF_KB), 768, (fb >> 6) * 96, rstd);
        else epi_vt(a0, a1, t, h, (bf16_t*)(p.ws + OFF_VB), 8, (fb - 512) >> 6, 64, 0, rstd);
      }
    }
    }
    __syncthreads();
  XCD_ITEMS_END
}

template <int DQK, int DV, bool WINDOW>
DI void attn_core(const Ctx cx, const bf16x8 (&qf)[DQK / 16], const bf16_t* __restrict__ Kb, int ldk, const bf16_t* __restrict__ VT,
                  int n_a, int t_b0, int n_b, int qpos, float& m, float& l, f32x16 (&O)[DV / 32], char* lds) {
  constexpr int KST = DQK * 2 + 16, VST = 136, CPR = DQK / 8, NS = DQK / 16, NO = DV / 32;
  constexpr int KBUF = 64 * KST, VBASE = 2 * KBUF, VBUF = DV * VST;
  const int tid = cx.tid, lane = tid & 63, l31 = lane & 31, h = lane >> 5;
  const int krow0 = tid / CPR, kch0 = tid - krow0 * CPR;
  const int krow1 = (tid + 512) / CPR, kch1 = (tid + 512) - krow1 * CPR;
  const bool k2 = (CPR == 12) && (tid < 256);
  const int vrow0 = tid >> 3, vch = tid & 7;
  uint4 rk0, rk1 = make_uint4(0, 0, 0, 0), rv0, rv1 = make_uint4(0, 0, 0, 0);
  const int nt = n_a + n_b;
  const int tb_adj = t_b0 - n_a;
  auto tile_of = [=](int it) { return it < n_a ? it : tb_adj + it; };
#define GLOAD(tile_) do { const int tl_ = (tile_); \
    rk0 = *(const uint4*)(Kb + (size_t)(tl_ * 64 + krow0) * ldk + kch0 * 8); \
    if (k2) rk1 = *(const uint4*)(Kb + (size_t)(tl_ * 64 + krow1) * ldk + kch1 * 8); \
    rv0 = *(const uint4*)(VT + (size_t)(vrow0) * RB + tl_ * 64 + vch * 8); \
    if (DV > 64) rv1 = *(const uint4*)(VT + (size_t)(vrow0 + 64) * RB + tl_ * 64 + vch * 8); } while (0)
#define VSTORE_(rv_, c_) do { char* d_ = lds + VBASE + bb_ * VBUF + (vrow0 + 64 * (c_)) * VST + vch * 16; \
      *(uint2*)d_ = make_uint2(rv_.x, rv_.y); *(uint2*)(d_ + 8) = make_uint2(rv_.z, rv_.w); } while (0)
#define LSTORE(b_) do { const int bb_ = (b_); \
    *(uint4*)(lds + bb_ * KBUF + krow0 * KST + kch0 * 16) = rk0; \
    if (k2) *(uint4*)(lds + bb_ * KBUF + krow1 * KST + kch1 * 16) = rk1; \
    VSTORE_(rv0, 0); if (DV > 64) VSTORE_(rv1, 1); } while (0)
  f32x16 negm, Lacc;
#pragma unroll
  for (int i = 0; i < 16; ++i) { negm[i] = -m; Lacc[i] = l; }
  bf16x8 ones;
#pragma unroll
  for (int i = 0; i < 8; ++i) ones[i] = (short)0x3F80;
  GLOAD(tile_of(0)); LSTORE(0);
  __syncthreads();
  for (int it = 0; it < nt; ++it) {
    const int cur = it & 1;
    const bool more = it + 1 < nt;
    if (more) GLOAD(tile_of(it + 1));
    f32x16 s0, s1;
    const char* kb = lds + cur * KBUF + l31 * KST + h * 16;
    {
      bf16x8 k0 = *(const bf16x8*)(kb), k1 = *(const bf16x8*)(kb + 32 * KST);
      s0 = MFMA(k0, qf[0], negm); s1 = MFMA(k1, qf[0], negm);
    }
#pragma unroll
    for (int s = 1; s < NS; ++s) {
      bf16x8 k0 = *(const bf16x8*)(kb + s * 32), k1 = *(const bf16x8*)(kb + 32 * KST + s * 32);
      s0 = MFMA(k0, qf[s], s0); s1 = MFMA(k1, qf[s], s1);
    }
    if (WINDOW) {
      const int tile = tile_of(it);
      if (tile >= 4) {
        const int kp0 = tile * 64 - NCTX + 4 * h - qpos;
#pragma unroll
        for (int i = 0; i < 16; ++i) {
          int d0 = kp0 + 8 * (i >> 2) + (i & 3), d1 = d0 + 32;
          if (d0 > 128 || d0 < -128) s0[i] = -1e30f;
          if (d1 > 128 || d1 < -128) s1[i] = -1e30f;
        }
      }
    }
    int im = max(__float_as_int(s0[0]), __float_as_int(s1[0]));
#pragma unroll
    for (int i = 1; i < 16; ++i) im = max(im, max(__float_as_int(s0[i]), __float_as_int(s1[i])));
    const bool force = (!WINDOW) && (it == 0);
    if (force || __any(im > 0x41000000)) {
      float tmax = fmaxf(s0[0], s1[0]);
#pragma unroll
      for (int i = 1; i < 16; ++i) tmax = fmaxf(tmax, fmaxf(s0[i], s1[i]));
      tmax = swap_max(tmax);
      const float d = force ? tmax : fmaxf(tmax, 0.f);
      m += d;
#pragma unroll
      for (int i = 0; i < 16; ++i) negm[i] = -m;
      if (!force) {
        const float alpha = __builtin_amdgcn_exp2f(-d);
#pragma unroll
        for (int i = 0; i < 16; ++i) Lacc[i] *= alpha;
#pragma unroll
        for (int o = 0; o < NO; ++o)
#pragma unroll
          for (int i = 0; i < 16; ++i) O[o][i] *= alpha;
      }
#pragma unroll
      for (int i = 0; i < 16; ++i) { s0[i] -= d; s1[i] -= d; }
    }
#pragma unroll
    for (int i = 0; i < 16; ++i) { s0[i] = __builtin_amdgcn_exp2f(s0[i]); s1[i] = __builtin_amdgcn_exp2f(s1[i]); }
    const char* vb = lds + VBASE + cur * VBUF + l31 * VST + h * 8;
#pragma unroll
    for (int mt = 0; mt < 2; ++mt)
#pragma unroll
      for (int s2 = 0; s2 < 2; ++s2) {
        const f32x16& sv = mt == 0 ? s0 : s1;
        unsigned pw[4];
#pragma unroll
        for (int j = 0; j < 4; ++j) pw[j] = pack2(sv[8 * s2 + 2 * j], sv[8 * s2 + 2 * j + 1]);
        bf16x8 pf = __builtin_bit_cast(bf16x8, make_uint4(pw[0], pw[1], pw[2], pw[3]));
        const int ko = (32 * mt + 16 * s2) * 2;
        Lacc = MFMA(ones, pf, Lacc);
#pragma unroll
        for (int o = 0; o < NO; ++o) {
          s16x4 lo = *(const s16x4*)(vb + o * 32 * VST + ko), hi = *(const s16x4*)(vb + o * 32 * VST + ko + 16);
          bf16x8 vf = __builtin_shufflevector(lo, hi, 0, 1, 2, 3, 4, 5, 6, 7);
          O[o] = MFMA(vf, pf, O[o]);
        }
      }
    if (more) LSTORE(cur ^ 1);
    __syncthreads();
  }
  l = Lacc[0];
}

template <int NS>
DI void load_q(bf16x8 (&qf)[NS], const bf16_t* __restrict__ qptr, int h) {
#pragma unroll
  for (int s = 0; s < NS; ++s) qf[s] = *(const bf16x8*)(qptr + 16 * s + 8 * h);
}
template <int NO>
DI void store_o(const f32x16 (&O)[NO], bf16_t* __restrict__ d, int h) {
#pragma unroll
  for (int o = 0; o < NO; ++o)
#pragma unroll
    for (int g = 0; g < 4; ++g) {
      uint2 w; w.x = pack2(O[o][4 * g], O[o][4 * g + 1]); w.y = pack2(O[o][4 * g + 2], O[o][4 * g + 3]);
      *(uint2*)(d + o * 32 + 8 * g + 4 * h) = w;
    }
}

DI void attn_phase(const Ctx cx0, const Params& p, int l, int slot, char* lds) {
  const int xcd = cx0.bid & 7;
  int* ctr = (int*)(p.ws + OFF_CTR) + slot * 8 + xcd;
  int* sh_item = (int*)(lds + LDS_MISC + 1024);
  const int NITEMS = (l == 0) ? 224 + 7 : 224;
  const float lam_init = 0.8f - 0.6f * __expf(-0.3f * (float)l);
  for (;;) {
    Ctx cx = cx0;
    asm volatile("" : "+v"(cx.tid));
    const int tid = cx.tid, lane = tid & 63, wave = tid >> 6, l31 = lane & 31, h = lane >> 5;
    if (tid == 0) *sh_item = atomicAdd(ctr, 1);
    __syncthreads();
    const int item = *sh_item;
    __syncthreads();
    if (item >= NITEMS) break;
    int br, b, head, qt; bool isctx = false;
    if (item < 32) { br = 0; b = xcd >> 2; head = xcd & 3; qt = item; }
    else if (item < 224) { int i = item - 32; br = 1 + (i >> 6); i &= 63; const int g = xcd + 8 * (i >> 5); b = g >> 3; head = g & 7; qt = i & 31; }
    else {
      isctx = true; qt = 0; int i = xcd * 7 + (item - 224);
      if (i < 8) { br = 0; b = i >> 2; head = i & 3; }
      else { i -= 8; br = 1 + (i >> 4); i &= 15; b = i >> 3; head = i & 7; }
    }
    const int r0 = b * RB + (isctx ? 0 : NCTX + qt * 256);
    const int rq = r0 + wave * 32 + l31;
    const int nka = isctx ? 4 : 132;
    if (br == 0) {
      const float* lv = p.diff_lambda + l * 256;
      float d1 = lv[lane] * lv[64 + lane], d2 = lv[128 + lane] * lv[192 + lane];
      d1 = wave_sum(d1); d2 = wave_sum(d2);
      const float lam = __expf(d1) - __expf(d2) + lam_init;
      const bf16_t* VT = (const bf16_t*)(p.ws + OFF_VA) + (size_t)(b * 4 + head) * 128 * RB;
      f32x16 O1[4];
#pragma unroll
      for (int o = 0; o < 4; ++o)
#pragma unroll
        for (int i = 0; i < 16; ++i) O1[o][i] = 0.f;
      float m1 = -100.f, l1 = 0.f, m2 = -100.f, l2 = 0.f;
      bf16_t* slot = (bf16_t*)(p.ws + OFF_QA) + (size_t)rq * 512 + head * 128;
      bf16x8 qa[4], qb[4];
      load_q<4>(qa, slot, h); load_q<4>(qb, slot + 64, h);
      attn_core<64, 128, false>(cx, qa, (const bf16_t*)(p.ws + OFF_KA) + (size_t)b * RB * 512 + (2 * head) * 64, 512, VT, nka, 0, 0, 0, m1, l1, O1, lds);
      const float i1 = 1.f / l1;
#pragma unroll
      for (int o = 0; o < 4; ++o)
#pragma unroll
        for (int i = 0; i < 16; ++i) O1[o][i] *= i1;
      store_o<4>(O1, slot, h);
#pragma unroll
      for (int o = 0; o < 4; ++o)
#pragma unroll
        for (int i = 0; i < 16; ++i) O1[o][i] = 0.f;
      attn_core<64, 128, false>(cx, qb, (const bf16_t*)(p.ws + OFF_KA) + (size_t)b * RB * 512 + (2 * head + 1) * 64, 512, VT, nka, 0, 0, 0, m2, l2, O1, lds);
      const float i2 = lam / l2;
      float ss = 0.f;
#pragma unroll
      for (int o = 0; o < 4; ++o)
#pragma unroll
        for (int g = 0; g < 4; ++g) {
          uint2 w = *(const uint2*)(slot + o * 32 + 8 * g + 4 * h);
          float a0 = __uint_as_float(w.x << 16) - O1[o][4 * g] * i2, a1 = __uint_as_float(w.x & 0xffff0000u) - O1[o][4 * g + 1] * i2;
          float a2 = __uint_as_float(w.y << 16) - O1[o][4 * g + 2] * i2, a3 = __uint_as_float(w.y & 0xffff0000u) - O1[o][4 * g + 3] * i2;
          O1[o][4 * g] = a0; O1[o][4 * g + 1] = a1; O1[o][4 * g + 2] = a2; O1[o][4 * g + 3] = a3;
          ss += a0 * a0 + a1 * a1 + a2 * a2 + a3 * a3;
        }
      ss = swap_sum(ss);
      const float rstd = rsqrtf(ss * (1.f / 128.f) + EPS) * (1.f - lam_init);
      const float* sg = p.diff_subln + l * 128;
#pragma unroll
      for (int o = 0; o < 4; ++o)
#pragma unroll
        for (int i = 0; i < 16; ++i) O1[o][i] *= rstd * sg[o * 32 + 8 * (i >> 2) + 4 * h + (i & 3)];
      store_o<4>(O1, (bf16_t*)(p.ws + OFF_QA) + (size_t)rq * 512 + head * 128, h);
    } else if (br == 1) {
      f32x16 O[2];
#pragma unroll
      for (int o = 0; o < 2; ++o)
#pragma unroll
        for (int i = 0; i < 16; ++i) O[o][i] = 0.f;
      float m = -100.f, ls = 0.f;
      bf16x8 qf[6]; load_q<6>(qf, (const bf16_t*)(p.ws + OFF_QB) + (size_t)rq * 768 + head * 96, h);
      attn_core<96, 64, false>(cx, qf,
                               (const bf16_t*)(p.ws + OFF_KB) + (size_t)b * RB * 768 + head * 96, 768,
                               (const bf16_t*)(p.ws + OFF_VB) + (size_t)(b * 8 + head) * 64 * RB, nka, 0, 0, 0, m, ls, O, lds);
      const float inv = 1.f / ls;
#pragma unroll
      for (int o = 0; o < 2; ++o)
#pragma unroll
        for (int i = 0; i < 16; ++i) O[o][i] *= inv;
      store_o<2>(O, (bf16_t*)(p.ws + OFF_OB) + (size_t)rq * 512 + head * 64, h);
    } else if (br == 2) {
      f32x16 O[2];
#pragma unroll
      for (int o = 0; o < 2; ++o)
#pragma unroll
        for (int i = 0; i < 16; ++i) O[o][i] = 0.f;
      float m = -100.f, ls = 0.f;
      const int kvh = head >> 2;
      bf16x8 qf[4]; load_q<4>(qf, (const bf16_t*)(p.ws + OFF_QC) + (size_t)rq * 512 + head * 64, h);
      attn_core<64, 64, false>(cx, qf,
                               (const bf16_t*)(p.ws + OFF_KC) + (size_t)b * RB * 128 + kvh * 64, 128,
                               (const bf16_t*)(p.ws + OFF_VC) + (size_t)(b * 2 + kvh) * 64 * RB, nka, 0, 0, 0, m, ls, O, lds);
      const float inv = 1.f / ls;
#pragma unroll
      for (int o = 0; o < 2; ++o)
#pragma unroll
        for (int i = 0; i < 16; ++i) O[o][i] *= inv;
      store_o<2>(O, (bf16_t*)(p.ws + OFF_QC) + (size_t)rq * 512 + head * 64, h);
    } else {
      f32x16 O[2];
#pragma unroll
      for (int o = 0; o < 2; ++o)
#pragma unroll
        for (int i = 0; i < 16; ++i) O[o][i] = 0.f;
      float m = p.swa_sink[l * 8 + head] * LOG2E, ls = 1.f;
      const int kvh = head >> 2;
      int tb0 = 0, nb = 0;
      if (!isctx) {
        int lo = max(2 * qt - 1, 0) * 128, hi = min(2 * qt + 3, 64) * 128;
        tb0 = 4 + (lo >> 6); nb = (hi - lo) >> 6;
      }
      bf16x8 qf[4]; load_q<4>(qf, (const bf16_t*)(p.ws + OFF_QD) + (size_t)rq * 512 + head * 64, h);
      attn_core<64, 64, true>(cx, qf,
                              (const bf16_t*)(p.ws + OFF_KD) + (size_t)b * RB * 128 + kvh * 64, 128,
                              (const bf16_t*)(p.ws + OFF_VD) + (size_t)(b * 2 + kvh) * 64 * RB, 4, tb0, nb, qt * 256 + wave * 32 + l31, m, ls, O, lds);
      const float inv = 1.f / ls;
#pragma unroll
      for (int o = 0; o < 2; ++o)
#pragma unroll
        for (int i = 0; i < 16; ++i) O[o][i] *= inv;
      store_o<2>(O, (bf16_t*)(p.ws + OFF_QD) + (size_t)rq * 512 + head * 64, h);
    }
  }
}

template <int MF>
DI void stage_tile(const Ctx cx, const f32x16 (&acc)[MF][2], float* U, int fbase_sub) {
  const int tid = cx.tid, lane = tid & 63, wave = tid >> 6, wn = wave & 3, l31 = lane & 31, h = lane >> 5;
#pragma unroll
  for (int ti = 0; ti < 2; ++ti)
#pragma unroll
    for (int fi = 0; fi < MF; ++fi)
#pragma unroll
      for (int g = 0; g < 4; ++g) {
        const int tokl = wn * 64 + ti * 32 + l31, fl = fbase_sub + fi * 32 + 8 * g + 4 * h;
        *(float4*)(U + tokl * 132 + fl) = make_float4(acc[fi][ti][4 * g], acc[fi][ti][4 * g + 1], acc[fi][ti][4 * g + 2], acc[fi][ti][4 * g + 3]);
      }
}
DI void merge_phase(const Ctx cx, const Params& p, int l, char* lds) {
  const int tid = cx.tid, wave = tid >> 6, wm = wave >> 2;
  const int fc = tid & 31, tr = tid >> 5;
  const bf16_t* H = (const bf16_t*)(p.ws + OFF_H);
  float* U = (float*)lds;
  const int ntt = l == 0 ? 66 : 64;
  XCD_ITEMS_BEGIN(ntt, 8)
    const int tt = tt_of(l, tti);
    float4 tot[16];
#pragma unroll
    for (int i = 0; i < 16; ++i) tot[i] = make_float4(0.f, 0.f, 0.f, 0.f);
#pragma unroll 1
    for (int k = 0; k < 4; ++k) {
      bf16_t* Mrow = (bf16_t*)(p.ws + OFF_M) + (size_t)(tt * 256 + tr) * 1024 + ft * 128 + 4 * fc;
      {
        f32x16 acc[2][2]; zero_acc<2>(acc);
        gemm_core<2>(cx, (const bf16_t*)(p.ws + OFF_WIN) + (size_t)(3840 + k * 1024 + ft * 128) * 1024, 1024, H, 1024, tt * 256, 0, R - 1, 1024, acc, lds);
        stage_tile<2>(cx, acc, U, wm * 64);
      }
      __syncthreads();
#pragma unroll
      for (int i = 0; i < 16; ++i) {
        const float4 u = *(const float4*)(U + (i * 16 + tr) * 132 + 4 * fc);
        uint2 g; g.x = pack2(sigmoid_f(u.x), sigmoid_f(u.y)); g.y = pack2(sigmoid_f(u.z), sigmoid_f(u.w));
        *(uint2*)(Mrow + (size_t)i * 16 * 1024) = g;
      }
      __syncthreads();
      {
        f32x16 acc[2][2]; zero_acc<2>(acc);
        const size_t xo = k == 0 ? OFF_QA : (k == 1 ? OFF_OB : (k == 2 ? OFF_QC : OFF_QD));
        gemm_core<2>(cx, (const bf16_t*)(p.ws + OFF_WBR) + (size_t)(k * 1024 + ft * 128) * 512, 512, (const bf16_t*)(p.ws + xo), 512, tt * 256, 0, R - 1, 512, acc, lds);
        stage_tile<2>(cx, acc, U, wm * 64);
      }
      __syncthreads();
#pragma unroll
      for (int i = 0; i < 16; ++i) {
        const float4 u = *(const float4*)(U + (i * 16 + tr) * 132 + 4 * fc);
        const uint2 g = *(const uint2*)(Mrow + (size_t)i * 16 * 1024);
        tot[i].x += __uint_as_float(g.x << 16) * u.x; tot[i].y += __uint_as_float(g.x & 0xffff0000u) * u.y;
        tot[i].z += __uint_as_float(g.y << 16) * u.z; tot[i].w += __uint_as_float(g.y & 0xffff0000u) * u.w;
      }
      __syncthreads();
    }
    bf16_t* M = (bf16_t*)(p.ws + OFF_M);
#pragma unroll
    for (int i = 0; i < 16; ++i) {
      uint2 o; o.x = pack2(tot[i].x, tot[i].y); o.y = pack2(tot[i].z, tot[i].w);
      *(uint2*)(M + (size_t)(tt * 256 + i * 16 + tr) * 1024 + ft * 128 + 4 * fc) = o;
    }
  XCD_ITEMS_END
}

template <int MF>
DI void resid_item(const Ctx cx, const Params& p, const float* modv, const bf16_t* W, int K, const bf16_t* X, bool from_inputs, int tt, int fbase, char* lds, int skip_epi) {
  constexpr int FH = MF == 4 ? 2 : 1, FW = MF == 4 ? 128 : 64 * MF;
  constexpr int LPR = FW / 4, RPP = 512 / LPR, NP = 256 / RPP;
  const int tid = cx.tid, wave = tid >> 6, wm = wave >> 2;
  const int fc = tid & (LPR - 1), tr = tid / LPR;
  float* U = (float*)lds;
  f32x16 acc[MF][2]; zero_acc<MF>(acc);
  gemm_core<MF>(cx, W + (size_t)fbase * K, K, X, K, tt * 256, 0, R - 1, K, acc, lds);
  if (skip_epi) { if (acc[0][0][0] == 12345.678f && acc[0][1][3] == 1.f) ((float*)(p.ws + OFF_CTR))[40] = 1.f; return; }
  const float* mv = modv + variant_of(tt * 256) * 6144;
#pragma unroll 1
  for (int fh = 0; fh < FH; ++fh) {
    if (MF == 4) { if (wm == fh) stage_tile<MF>(cx, acc, U, 0); }
    else stage_tile<MF>(cx, acc, U, wm * 32 * MF);
    __syncthreads();
    const int f = fbase + fh * 128 + 4 * fc;
    const float4 mm = *(const float4*)(mv + f);
    const float* xs0 = x_row_src(p, from_inputs, tt * 256) + (size_t)tr * 1024 + f;
    float* xd0 = x_row_dst(p, tt * 256) + (size_t)tr * 1024 + f;
    const float* up = U + tr * 132 + 4 * fc;
#pragma unroll 1
    for (int i4 = 0; i4 < NP / 4; ++i4) {
      float4 xo[4];
#pragma unroll
      for (int j = 0; j < 4; ++j) xo[j] = *(const float4*)(xs0 + (size_t)(i4 * 4 + j) * RPP * 1024);
#pragma unroll
      for (int j = 0; j < 4; ++j) {
        const float4 u = *(const float4*)(up + (i4 * 4 + j) * RPP * 132);
        float4 o = xo[j];
        o.x += mm.x * u.x; o.y += mm.y * u.y; o.z += mm.z * u.z; o.w += mm.w * u.w;
        *(float4*)(xd0 + (size_t)(i4 * 4 + j) * RPP * 1024) = o;
      }
    }
    __syncthreads();
  }
}
DI void resid_gemm_phase(const Ctx cx, const Params& p, int l, const bf16_t* W, int K, const bf16_t* X, int midx, bool from_inputs, char* lds, int skip_epi = 0) {
  const float* modv = (const float*)(p.ws + OFF_MODV) + (size_t)l * 3 * 6144 + midx * 1024;
  XCD_ITEMS_BEGIN(64, 4)
    resid_item<4>(cx, p, modv, W, K, X, from_inputs, tt_of(1, tti), ft * 256, lds, skip_epi);
  XCD_ITEMS_END
  if (l == 0)
    for (int q = cx.bid; q < 32; q += (int)gridDim.x) resid_item<1>(cx, p, modv, W, K, X, from_inputs, (q >> 4) ? 33 : 0, (q & 15) * 64, lds, skip_epi);
}

DI void ffn_up_phase(const Ctx cx, const Params& p, int l, char* lds) {
  const int tid = cx.tid, lane = tid & 63, wave = tid >> 6, wm = wave >> 2, wn = wave & 3, l31 = lane & 31, h = lane >> 5;
  const bf16_t* H = (const bf16_t*)(p.ws + OFF_H);
  const bf16_t* W = (const bf16_t*)(p.ws + OFF_WUP);
  bf16_t* ACT = (bf16_t*)(p.ws + OFF_ACT);
  float* U = (float*)lds;
  const int ntk = l == 0 ? 68 : 66;
  const float* cw = p.ffn_conv_w + (size_t)l * 3 * 5632;
  const float* cb = p.ffn_conv_b + (size_t)l * 5632;
  XCD_ITEMS_BEGIN(ntk, 22)
    const int tk = tti;
    int rs, len, ti_; bool isctx = false;
    if (l == 0) { int b = tk / 34, i = tk % 34; if (i < 1) { rs = b * RB; len = NCTX; ti_ = 0; isctx = true; } else { rs = b * RB + NCTX; len = NMAIN; ti_ = i - 1; } }
    else { int b = tk / 33; rs = b * RB + NCTX; len = NMAIN; ti_ = tk % 33; }
    const int q0 = isctx ? 0 : 254 * ti_ - 1;
    f32x16 acc[4][2]; zero_acc<4>(acc);
    gemm_core<4, true>(cx, W + (size_t)ft * 256 * 1024, 1024, H, 1024, rs + q0, rs, rs + len - 1, 1024, acc, lds);
#pragma unroll 1
    for (int fh = 0; fh < 2; ++fh) {
      if (wm == fh) {
#pragma unroll
        for (int ti = 0; ti < 2; ++ti)
#pragma unroll
          for (int fi = 0; fi < 4; ++fi)
#pragma unroll
            for (int g = 0; g < 4; ++g) {
              const int tokl = wn * 64 + ti * 32 + l31, fl = fi * 32 + 8 * g + 4 * h;
              *(float4*)(U + tokl * 132 + fl) = make_float4(acc[fi][ti][4 * g], acc[fi][ti][4 * g + 1], acc[fi][ti][4 * g + 2], acc[fi][ti][4 * g + 3]);
            }
      }
      __syncthreads();
      {
        const int j = tid & 63, c = tid >> 6;
        const int fv = ft * 128 + fh * 64 + j, fg = 2816 + fv;
        const float wv0 = cw[fv], wv1 = cw[5632 + fv], wv2 = cw[2 * 5632 + fv], bv = cb[fv];
        const float wg0 = cw[fg], wg1 = cw[5632 + fg], wg2 = cw[2 * 5632 + fg], bg = cb[fg];
        const int t0 = (isctx ? 0 : 1) + 32 * c, t1 = min(t0 + 32, isctx ? 256 : 255);
        float pv = (q0 + t0 - 1 >= 0) ? U[(t0 - 1) * 132 + j] : 0.f, pg = (q0 + t0 - 1 >= 0) ? U[(t0 - 1) * 132 + 64 + j] : 0.f;
        float cv = U[t0 * 132 + j], cgt = U[t0 * 132 + 64 + j];
        for (int t = t0; t < t1; ++t) {
          const int q = q0 + t;
          if (q >= len) break;
          float nv = (q + 1 < len) ? U[(t + 1) * 132 + j] : 0.f, ng = (q + 1 < len) ? U[(t + 1) * 132 + 64 + j] : 0.f;
          float val = wv0 * pv + wv1 * cv + wv2 * nv + bv;
          float gat = wg0 * pg + wg1 * cgt + wg2 * ng + bg;
          float a = silu_f(gat) * val;
          ACT[(size_t)(rs + q) * 2816 + fv] = (bf16_t)(pack2(a, 0.f) & 0xffff);
          pv = cv; pg = cgt; cv = nv; cgt = ng;
        }
      }
      __syncthreads();
    }
  XCD_ITEMS_END
}

DI void final_phase(const Ctx cx, const Params& p) {
  const int tid = cx.tid, lane = tid & 63, wave = tid >> 6;
  const int rstride = (int)gridDim.x * 8;
  for (int r0 = cx.bid * 8 + wave; r0 < 2 * NMAIN; r0 += 2 * rstride) {
    const int r1 = r0 + rstride; const bool on1 = r1 < 2 * NMAIN;
    float4 xa[4], xb[4];
#pragma unroll
    for (int i = 0; i < 4; ++i) xa[i] = *(const float4*)(p.out + (size_t)r0 * DM + i * 256 + lane * 4);
    if (on1) {
#pragma unroll
      for (int i = 0; i < 4; ++i) xb[i] = *(const float4*)(p.out + (size_t)r1 * DM + i * 256 + lane * 4);
    }
#pragma unroll
    for (int rr = 0; rr < 2; ++rr) {
      if (rr == 1 && !on1) continue;
      float* xr = p.out + (size_t)(rr == 0 ? r0 : r1) * DM;
      float4 xv[4]; float ss = 0.f;
#pragma unroll
      for (int i = 0; i < 4; ++i) { xv[i] = rr == 0 ? xa[i] : xb[i]; ss += xv[i].x * xv[i].x + xv[i].y * xv[i].y + xv[i].z * xv[i].z + xv[i].w * xv[i].w; }
      ss = wave_sum(ss);
      const float rstd = rsqrtf(ss * (1.f / 1024.f) + EPS);
#pragma unroll
      for (int i = 0; i < 4; ++i) {
        float4 g = *(const float4*)(p.final_norm + i * 256 + lane * 4);
        float4 o = make_float4(xv[i].x * rstd * g.x, xv[i].y * rstd * g.y, xv[i].z * rstd * g.z, xv[i].w * rstd * g.w);
        *(float4*)(xr + i * 256 + lane * 4) = o;
      }
    }
  }
}

#define XB_TMO      128
#define XB_XCNT(j)  (256  + 64 * (j))
#define XB_XSUB(j)  (1280 + 64 * (j))
#define XB_XGEN(j)  (2304 + 64 * (j))
#define XB_TOP      3328
#define XB_TOPGEN   3392
#define XCD_BAR_WORDS 3456
#define XB_SPIN_CAP (1u << 20)
#define LAS __attribute__((address_space(3)))
DI unsigned xb_ld(unsigned* p)              { return __hip_atomic_load(p, __ATOMIC_RELAXED, __HIP_MEMORY_SCOPE_AGENT); }
DI unsigned xb_add(unsigned* p, unsigned v) { return __hip_atomic_fetch_add(p, v, __ATOMIC_RELAXED, __HIP_MEMORY_SCOPE_AGENT); }
DI unsigned xb_xcc_id() { return (unsigned)__builtin_amdgcn_s_getreg((3 << 11) | 20) & 0xFu; }
#define XB_SPIN(cond, bar) do { unsigned _sp = 0; while (cond) { __builtin_amdgcn_s_sleep(1); \
    if ((++_sp & 255u) == 0u) { if (xb_ld(&(bar)[XB_TMO])) break; if (_sp > XB_SPIN_CAP) { atomicAdd(&(bar)[XB_TMO], 1u); break; } } } } while (0)
struct XcdBarrier { unsigned* bar; unsigned x; volatile LAS unsigned* st; };
DI XcdBarrier xcd_barrier_post(unsigned* bar, volatile LAS unsigned* st) {
  XcdBarrier b; b.bar = bar; b.x = xb_xcc_id(); b.st = st;
  if (threadIdx.x == 0) (void)xb_add(&bar[XB_XCNT(b.x)], 1u);
  return b;
}
DI void xcd_barrier_complete(unsigned* bar, unsigned x, unsigned& nloc, unsigned& nx) {
  const unsigned G = gridDim.x * gridDim.y * gridDim.z;
  unsigned sum, cnt, mine, sp = 0u;
  for (;;) {
    sum = 0u; cnt = 0u; mine = 0u;
#pragma unroll
    for (unsigned j = 0; j < 16; ++j) { const unsigned c = xb_ld(&bar[XB_XCNT(j)]); sum += c; cnt += (c > 0u) ? 1u : 0u; mine = (j == x) ? c : mine; }
    if (sum == G) break;
    __builtin_amdgcn_s_sleep(1);
    if ((++sp & 255u) == 0u) { if (xb_ld(&bar[XB_TMO])) break; if (sp > XB_SPIN_CAP) { atomicAdd(&bar[XB_TMO], 1u); break; } }
  }
  nloc = mine > 0u ? mine : 1u; nx = cnt > 0u ? cnt : 1u;
}
DI void xcd_barrier(const XcdBarrier& b, const int tid) {
  asm volatile("s_waitcnt vmcnt(0)" ::: "memory");
  __syncthreads();
  if (tid == 0) {
    unsigned* bar = b.bar;
    __builtin_amdgcn_s_waitcnt(0);
    unsigned nloc = b.st[0], nx = b.st[1];
    if (nloc == 0u) { xcd_barrier_complete(bar, b.x, nloc, nx); b.st[0] = nloc; b.st[1] = nx; }
    const unsigned old = xb_add(&bar[XB_XSUB(b.x)], 1u);
    const unsigned gen = old / nloc;
    if (old + 1u == (gen + 1u) * nloc) {
      __builtin_amdgcn_fence(__ATOMIC_RELEASE, "agent");
      asm volatile("s_waitcnt vmcnt(0)" ::: "memory");
      const unsigned og = xb_add(&bar[XB_TOP], 1u);
      const unsigned tg = og / nx;
      if (og + 1u == (tg + 1u) * nx) xb_add(&bar[XB_TOPGEN], 1u);
      else XB_SPIN(xb_ld(&bar[XB_TOPGEN]) == tg, bar);
      __builtin_amdgcn_fence(__ATOMIC_ACQUIRE, "agent");
      xb_add(&bar[XB_XGEN(b.x)], 1u);
      asm volatile("s_waitcnt vmcnt(0)" ::: "memory");
    } else {
      XB_SPIN(xb_ld(&bar[XB_XGEN(b.x)]) == gen, bar);
      __builtin_amdgcn_fence(__ATOMIC_ACQUIRE, "agent");
      asm volatile("s_waitcnt vmcnt(0)" ::: "memory");
    }
  }
  __syncthreads();
}

constexpr int NPHASES = 20;
DI void run_phase(const Ctx cx, const Params& p, int ph, char* lds, int slot_add = 0) {
  if (ph == 0) { prep0(cx, p, lds); return; }
  if (ph == NPHASES - 1) { final_phase(cx, p); return; }
  const int l = (ph - 1) / 9, s = (ph - 1) % 9;
  switch (s) {
    case 0: if (l == 1) convert_mix(cx, p, 1, lds); norm_phase(cx, p, l, 0, l == 0, l == 0, false, lds); break;
    case 1: gemm_in_phase(cx, p, l, lds, slot_add >= 100); break;
    case 2: gemm_mla_phase(cx, p, lds); break;
    case 3: attn_phase(cx, p, l, l + slot_add, lds); break;
    case 4: merge_phase(cx, p, l, lds); break;
    case 5: resid_gemm_phase(cx, p, l, (const bf16_t*)(p.ws + OFF_WOUT), 1024, (const bf16_t*)(p.ws + OFF_M), 2, l == 0, lds, slot_add >= 100); break;
    case 6: convert_ffn(cx, p, l, lds); norm_phase(cx, p, l, 1, false, false, l == 1, lds); break;
    case 7: ffn_up_phase(cx, p, l, lds); break;
    case 8: resid_gemm_phase(cx, p, l, (const bf16_t*)(p.ws + OFF_WDN), 2816, (const bf16_t*)(p.ws + OFF_ACT), 5, false, lds); break;
  }
}

__global__ void __launch_bounds__(512, 2) mega(Params p, int ph_lo, int ph_hi) {
  extern __shared__ __attribute__((aligned(16))) char lds[];
  __shared__ uint4 xb_words;
  if (threadIdx.x == 0) xb_words = make_uint4(0u, 0u, 0u, 0u);
  __syncthreads();
  const XcdBarrier xb = xcd_barrier_post((unsigned*)(p.ws + OFF_BAR), (volatile LAS unsigned*)&xb_words);
#define GRID_SYNC(PH) do { if ((PH) == 0) cg::this_grid().sync(); else xcd_barrier(xb, cx.tid); } while (0)
#define STEP(PH) if (ph_lo <= (PH) && (PH) < ph_hi) { \
    Ctx cx; cx.tid = __builtin_amdgcn_workitem_id_x(); cx.bid = __builtin_amdgcn_workgroup_id_x(); \
    asm volatile("" : "+v"(cx.tid)); asm volatile("" : "+v"(cx.bid)); cx.bid = __builtin_amdgcn_readfirstlane(cx.bid); \
    Params q = p; int zoff = 0; asm volatile("" : "+v"(zoff)); zoff = __builtin_amdgcn_readfirstlane(zoff); q.ws = p.ws + (size_t)(unsigned)zoff; \
    run_phase(cx, q, (PH), lds); \
    if ((PH) + 1 < ph_hi) GRID_SYNC(PH); }
#define RSTEP(PH, SA) { Ctx cx; cx.tid = __builtin_amdgcn_workitem_id_x(); cx.bid = __builtin_amdgcn_workgroup_id_x(); \
    asm volatile("" : "+v"(cx.tid)); asm volatile("" : "+v"(cx.bid)); cx.bid = __builtin_amdgcn_readfirstlane(cx.bid); \
    Params q = p; int zoff = 0; asm volatile("" : "+v"(zoff)); zoff = __builtin_amdgcn_readfirstlane(zoff); q.ws = p.ws + (size_t)(unsigned)zoff; \
    int sa_ = (SA); asm volatile("" : "+v"(sa_)); sa_ = __builtin_amdgcn_readfirstlane(sa_); run_phase(cx, q, (PH), lds, sa_); xcd_barrier(xb, cx.tid); }
#if PROBE == 0
  STEP(0) STEP(1) STEP(2) STEP(3) STEP(4) STEP(5) STEP(6) STEP(7) STEP(8) STEP(9)
#elif PROBE == 1
  STEP(0) STEP(1) STEP(2) RSTEP(2, 0) STEP(3) STEP(4) STEP(5) STEP(6) STEP(7) STEP(8) STEP(9)
#elif PROBE == 2
  STEP(0) STEP(1) STEP(2) STEP(3) STEP(4) RSTEP(2, 0) RSTEP(3, 0) RSTEP(4, 2) STEP(5) STEP(6) STEP(7) STEP(8) STEP(9)
#elif PROBE == 3
  STEP(0) STEP(1) STEP(2) STEP(3) STEP(4) STEP(5) RSTEP(5, 0) STEP(6) STEP(7) STEP(8) STEP(9)
#elif PROBE == 7
  STEP(0) RSTEP(0, 0) STEP(1) STEP(2) STEP(3) STEP(4) STEP(5) STEP(6) STEP(7) STEP(8) STEP(9)
#elif PROBE == 8
  STEP(0) STEP(1) STEP(2) STEP(3) STEP(4) STEP(5) STEP(6) STEP(7) RSTEP(7, 0) STEP(8) STEP(9)
#elif PROBE == 9
  STEP(0) STEP(1) RSTEP(1, 0) STEP(2) STEP(3) RSTEP(3, 0) STEP(4) STEP(5) STEP(6) STEP(7) STEP(8) STEP(9)
#elif PROBE == 10
  STEP(0) STEP(1) STEP(2) RSTEP(2, 100) STEP(3) STEP(4) STEP(5) STEP(6) RSTEP(6, 100) STEP(7) STEP(8) STEP(9)
#elif PROBE == 5
  STEP(0) STEP(1) STEP(2) STEP(3) STEP(4) STEP(5) STEP(6) RSTEP(6, 0) STEP(7) STEP(8) STEP(9)
#elif PROBE == 6
  STEP(0) STEP(1) STEP(2) STEP(3) STEP(4) STEP(5) STEP(6) STEP(7) STEP(8) RSTEP(8, 0) STEP(9)
#elif PROBE == 4
  STEP(0) RSTEP(0, 0) STEP(1) RSTEP(1, 0) STEP(2) STEP(3) RSTEP(3, 0) STEP(4) STEP(5) STEP(6) STEP(7) RSTEP(7, 0) STEP(8) STEP(9)
#endif
  STEP(10) STEP(11) STEP(12) STEP(13) STEP(14) STEP(15) STEP(16) STEP(17) STEP(18) STEP(19)
}

extern "C" void kernel_launch(void* const* d_in, const int* in_sizes, int n_in, void* d_out, int out_size, void* d_ws, size_t ws_size, hipStream_t stream) {
  static int grid_blocks = 0;
  if (!grid_blocks) {
    hipFuncSetAttribute((const void*)mega, hipFuncAttributeMaxDynamicSharedMemorySize, LDS_BYTES);
    int dev = 0, cus = 0, per_cu = 0;
    hipGetDevice(&dev);
    hipDeviceGetAttribute(&cus, hipDeviceAttributeMultiprocessorCount, dev);
    hipOccupancyMaxActiveBlocksPerMultiprocessor(&per_cu, mega, NTH, LDS_BYTES);
    if (per_cu > 1) per_cu = 1;
    if (per_cu < 1) per_cu = 1;
    grid_blocks = cus * per_cu;
    if (ws_size < WS_NEED) fprintf(stderr, "workspace too small: %zu < %zu\n", ws_size, (size_t)WS_NEED);
  }
  Params p{};
  const float* const* in = (const float* const*)d_in;
  p.x = in[0]; p.c = in[1]; p.ctx = in[2]; p.c_ctx = in[3]; p.w_mod = in[4]; p.b_mod = in[5]; p.w_in = in[6]; p.diff_lambda = in[7];
  p.diff_subln = in[8]; p.mla_q_norm = in[9]; p.mla_kv_norm = in[10]; p.mla_w_uq = in[11]; p.mla_w_ukv = in[12]; p.gqa_q_norm = in[13];
  p.gqa_k_norm = in[14]; p.swa_sink = in[15]; p.w_branch = in[16]; p.w_out = in[17]; p.ffn_w_up = in[18]; p.ffn_conv_w = in[19];
  p.ffn_conv_b = in[20]; p.ffn_w_down = in[21]; p.final_norm = in[22];
  p.out = (float*)d_out; p.ws = (char*)d_ws;
#if MK_COOP
  hipMemsetAsync((char*)d_ws + OFF_BAR, 0, XCD_BAR_WORDS * sizeof(unsigned), stream);
  int lo = 0, hi = NPHASES;
  void* args[] = {&p, &lo, &hi};
  hipError_t e = hipLaunchCooperativeKernel((const void*)mega, dim3(grid_blocks), dim3(NTH), args, LDS_BYTES, stream);
  if (e != hipSuccess) fprintf(stderr, "cooperative launch failed: %s (grid %d)\n", hipGetErrorString(e), grid_blocks);
#else
  for (int ph = 0; ph < NPHASES; ++ph) hipLaunchKernelGGL(mega, dim3(grid_blocks), dim3(NTH), LDS_BYTES, stream, p, ph, ph + 1);
#endif
}
```

```cpp
#include <hip/hip_runtime.h>
#include <hip/hip_cooperative_groups.h>
#include <cstdio>
#include <cstdint>
namespace cg = cooperative_groups;

#ifndef PROBE
#define PROBE 0
#endif
#ifndef MK_COOP
#define MK_COOP 1
#endif

typedef unsigned short bf16_t;
typedef short bf16x8 __attribute__((ext_vector_type(8)));
typedef short s16x4 __attribute__((ext_vector_type(4)));
typedef float f32x16 __attribute__((ext_vector_type(16)));
typedef float f32x4 __attribute__((ext_vector_type(4)));
typedef __bf16 bf16x2_t __attribute__((ext_vector_type(2)));
#define DI __device__ __forceinline__
struct Ctx { int tid, bid; };
#define MFMA(a, b, c) __builtin_amdgcn_mfma_f32_32x32x16_bf16((a), (b), (c), 0, 0, 0)

constexpr int R = 16896, RB = 8448, NMAIN = 8192, NCTX = 256, DM = 1024;
constexpr int LDS_BYTES = 139264;
constexpr int NTH = 512;
constexpr int LDS_MISC = 131072;
constexpr float EPS = 1e-6f;
constexpr float LOG2E = 1.4426950408889634f;

constexpr size_t SZ_R512 = (size_t)R * 512 * 2, SZ_R128 = (size_t)R * 128 * 2, SZ_R768 = (size_t)R * 768 * 2, SZ_R1024 = (size_t)R * 1024 * 2;
constexpr size_t OFF_CTR = 0;
constexpr size_t OFF_MODP = 256;
constexpr size_t OFF_MODV = OFF_MODP + (size_t)2 * 8 * 3 * 6144 * 4;
constexpr size_t OFF_T64 = OFF_MODV + (size_t)2 * 3 * 6144 * 4;
constexpr size_t OFF_T32 = OFF_T64 + 128 * 16 * 8;
constexpr size_t OFF_XCTX = OFF_T32 + 128 * 8 * 8;
constexpr size_t OFF_WIN = OFF_XCTX + (size_t)512 * 1024 * 4;
constexpr size_t OFF_WUQ = OFF_WIN + (size_t)7936 * 1024 * 2;
constexpr size_t OFF_WUKV = OFF_WUQ + (size_t)768 * 256 * 2;
constexpr size_t OFF_WBR = OFF_WUKV + (size_t)1024 * 256 * 2;
constexpr size_t OFF_WOUT = OFF_WBR + (size_t)4 * 1024 * 512 * 2;
constexpr size_t OFF_H = OFF_WOUT + (size_t)1024 * 1024 * 2;
constexpr size_t OFF_BIG = OFF_H + SZ_R1024;
constexpr size_t OFF_QA = OFF_BIG;
constexpr size_t OFF_KA = OFF_QA + SZ_R512;
constexpr size_t OFF_VA = OFF_KA + SZ_R512;
constexpr size_t OFF_QC = OFF_VA + SZ_R512;
constexpr size_t OFF_KC = OFF_QC + SZ_R512;
constexpr size_t OFF_VC = OFF_KC + SZ_R128;
constexpr size_t OFF_QD = OFF_VC + SZ_R128;
constexpr size_t OFF_KD = OFF_QD + SZ_R512;
constexpr size_t OFF_VD = OFF_KD + SZ_R128;
constexpr size_t OFF_QB = OFF_VD + SZ_R128;
constexpr size_t OFF_KB = OFF_QB + SZ_R768;
constexpr size_t OFF_VB = OFF_KB + SZ_R768;
constexpr size_t OFF_OB = OFF_VB + SZ_R512;
constexpr size_t OFF_END_MIX = OFF_OB + SZ_R512;
constexpr size_t OFF_M = OFF_KA;
constexpr size_t OFF_WUP = OFF_BIG;
constexpr size_t OFF_WDN = OFF_WUP + (size_t)5632 * 1024 * 2;
constexpr size_t OFF_ACT = OFF_WDN + (size_t)1024 * 2816 * 2;
constexpr size_t OFF_END_FFN = OFF_ACT + (size_t)R * 2816 * 2;
constexpr size_t OFF_BAR = ((OFF_END_MIX > OFF_END_FFN ? OFF_END_MIX : OFF_END_FFN) + 4095) / 4096 * 4096;
constexpr size_t WS_NEED = OFF_BAR + 16384;

struct Params {
  const float *x, *c, *ctx, *c_ctx, *w_mod, *b_mod, *w_in, *diff_lambda, *diff_subln, *mla_q_norm, *mla_kv_norm, *mla_w_uq, *mla_w_ukv,
      *gqa_q_norm, *gqa_k_norm, *swa_sink, *w_branch, *w_out, *ffn_w_up, *ffn_conv_w, *ffn_conv_b, *ffn_w_down, *final_norm;
  float* out;
  char* ws;
};

DI unsigned pack2(float a, float b) { bf16x2_t v; v.x = (__bf16)a; v.y = (__bf16)b; return __builtin_bit_cast(unsigned, v); }
DI float bf2f(bf16_t v) { return __uint_as_float(((unsigned)v) << 16); }
DI float swap_max(float x) { auto r = __builtin_amdgcn_permlane32_swap(__float_as_uint(x), __float_as_uint(x), false, false); return fmaxf(__uint_as_float(r[0]), __uint_as_float(r[1])); }
DI float swap_sum(float x) { auto r = __builtin_amdgcn_permlane32_swap(__float_as_uint(x), __float_as_uint(x), false, false); return __uint_as_float(r[0]) + __uint_as_float(r[1]); }
DI float wave_sum(float v) { for (int o = 32; o > 0; o >>= 1) v += __shfl_xor(v, o); return v; }
DI float silu_f(float v) { return v / (1.f + __expf(-v)); }
DI float sigmoid_f(float v) { return 1.f / (1.f + __expf(-v)); }
DI const float* x_row_src(const Params& p, bool from_inputs, int r) {
  int b = r >= RB ? 1 : 0, pp = r - b * RB;
  if (pp < NCTX) return (from_inputs ? p.ctx : (const float*)(p.ws + OFF_XCTX)) + (size_t)(b * NCTX + pp) * DM;
  return (from_inputs ? p.x : (const float*)p.out) + (size_t)(b * NMAIN + pp - NCTX) * DM;
}
DI float* x_row_dst(const Params& p, int r) {
  int b = r >= RB ? 1 : 0, pp = r - b * RB;
  if (pp < NCTX) return (float*)(p.ws + OFF_XCTX) + (size_t)(b * NCTX + pp) * DM;
  return p.out + (size_t)(b * NMAIN + pp - NCTX) * DM;
}
DI int variant_of(int r) { int b = r >= RB ? 1 : 0, pp = r - b * RB; return pp < NCTX ? 2 : b; }
DI int tt_of(int layer, int idx) { return layer == 0 ? idx : (idx >> 5) * 33 + 1 + (idx & 31); }

#define XCD_ITEMS_BEGIN(NT_, NF_) { const int nbx_ = (int)gridDim.x >> 3, xx_ = cx.bid & 7, nown_ = (NT_) >> 3, town_ = nown_ * (NF_); \
  const int nlo_ = ((NT_) - 8 * nown_) * (NF_), text_ = (nlo_ > xx_) ? (nlo_ - xx_ + 7) >> 3 : 0;     \
  for (int q_ = cx.bid >> 3; q_ < town_ + text_; q_ += nbx_) { int ft, tti; \
    if (q_ < town_) { const int g_ = q_ / (8 * (NF_)), r_ = q_ - g_ * 8 * (NF_), gs_ = min(8, nown_ - 8 * g_); \
      ft = r_ / gs_; tti = xx_ + 8 * (8 * g_ + (r_ - ft * gs_)); } \
    else { const int e_ = xx_ + 8 * (q_ - town_); tti = 8 * nown_ + e_ / (NF_); ft = e_ - (tti - 8 * nown_) * (NF_); }
#define XCD_ITEMS_END } }
template <int MF, bool CLAMP = false>
DI void gemm_core(const Ctx cx, const bf16_t* __restrict__ W, int ldw, const bf16_t* __restrict__ X, int ldx, int rbase, int rlo, int rhi, int K,
                  f32x16 (&acc)[MF][2], char* lds) {
  constexpr int AB = 64 * MF * 128, SS = AB + 32768;
  const int tid = cx.tid, lane = tid & 63, wave = tid >> 6, wm = wave >> 2, wn = wave & 3, l31 = lane & 31, h = lane >> 5;
  const int srow = tid >> 3, sch = (tid & 7) ^ ((srow >> 1) & 7);
  const bf16_t* wp = W + (size_t)srow * ldw + sch * 8;
  const bf16_t* xp[4];
  if (CLAMP) {
#pragma unroll
    for (int c = 0; c < 4; ++c) { int xr = min(max(rbase + srow + 64 * c, rlo), rhi); xp[c] = X + (size_t)xr * ldx + sch * 8; }
  } else {
    xp[0] = X + (size_t)(rbase + srow) * ldx + sch * 8;
  }
  char* lw = lds + tid * 16;
  const int swz = (l31 >> 1) & 7;
  const int offA = (wm * 32 * MF + l31) * 128, offB = AB + (wn * 64 + l31) * 128;
  const int nk = K >> 6;
#define GSTAGE(buf_, ko_) do { char* d_ = lw + (buf_) * SS; \
    _Pragma("unroll") for (int c = 0; c < MF; ++c) \
      __builtin_amdgcn_global_load_lds((const unsigned*)(wp + (size_t)(64 * c) * ldw + (ko_)), (__attribute__((address_space(3))) unsigned*)(d_ + 8192 * c), 16, 0, 0); \
    _Pragma("unroll") for (int c = 0; c < 4; ++c) \
      __builtin_amdgcn_global_load_lds((const unsigned*)((CLAMP ? xp[c] : xp[0] + (size_t)(64 * c) * ldx) + (ko_)), (__attribute__((address_space(3))) unsigned*)(d_ + AB + 8192 * c), 16, 0, 0); } while (0)
  GSTAGE(0, 0);
  __syncthreads();
  int buf = 0;
  for (int kt = 0; kt < nk; ++kt) {
    if (kt + 1 < nk) GSTAGE(buf ^ 1, (kt + 1) * 64);
    const char* base = lds + buf * SS;
    bf16x8 a[2][MF], b[2][2];
    {
      const int co = (h ^ swz) << 4;
#pragma unroll
      for (int fi = 0; fi < MF; ++fi) a[0][fi] = *(const bf16x8*)(base + offA + fi * 4096 + co);
      b[0][0] = *(const bf16x8*)(base + offB + co); b[0][1] = *(const bf16x8*)(base + offB + 4096 + co);
    }
#pragma unroll
    for (int s = 0; s < 4; ++s) {
      if (s < 3) {
        const int co = ((2 * (s + 1) + h) ^ swz) << 4;
#pragma unroll
        for (int fi = 0; fi < MF; ++fi) a[(s + 1) & 1][fi] = *(const bf16x8*)(base + offA + fi * 4096 + co);
        b[(s + 1) & 1][0] = *(const bf16x8*)(base + offB + co); b[(s + 1) & 1][1] = *(const bf16x8*)(base + offB + 4096 + co);
      }
#pragma unroll
      for (int fi = 0; fi < MF; ++fi) { acc[fi][0] = MFMA(a[s & 1][fi], b[s & 1][0], acc[fi][0]); acc[fi][1] = MFMA(a[s & 1][fi], b[s & 1][1], acc[fi][1]); }
    }
    __syncthreads();
    buf ^= 1;
  }
#undef GSTAGE
}
template <int MF>
DI void zero_acc(f32x16 (&acc)[MF][2]) {
#pragma unroll
  for (int a = 0; a < MF; ++a)
#pragma unroll
    for (int b = 0; b < 2; ++b)
#pragma unroll
      for (int i = 0; i < 16; ++i) acc[a][b][i] = 0.f;
}

DI int rowmap_win(int n) {
  if (n < 1536) return n;
  if (n < 1792) return 3072 + (n - 1536);
  if (n < 2048) return 3328 + (n - 1792);
  if (n < 2080) return 3584 + (n - 2048);
  if (n < 2592) return 1536 + (n - 2080);
  if (n < 2720) return 2048 + (n - 2592);
  if (n < 2848) return 2176 + (n - 2720);
  if (n < 3360) return 2304 + (n - 2848);
  if (n < 3488) return 2816 + (n - 3360);
  if (n < 3616) return 2944 + (n - 3488);
  return 3840 + (n - 3616);
}
DI int rowmap(int mode, int n) {
  switch (mode) {
    case 1: return rowmap_win(n);
    case 2: { int hd = n / 96, d = n - hd * 96; return d < 64 ? hd * 64 + d : 512 + hd * 32 + (d - 64); }
    case 3: { int hd = n >> 7, d = n & 127; return d < 64 ? hd * 64 + d : 512 + hd * 64 + (d - 64); }
    case 4: { if (n < 2816) return 128 * (n >> 6) + (n & 63); int f = n - 2816; return 128 * (f >> 6) + 64 + (f & 63); }
    default: return n;
  }
}
DI void convert_tile(const Ctx cx, const float* __restrict__ src, int N, bf16_t* __restrict__ dst, int ldd, int mode, const float* __restrict__ kscale, int kt, int nt, char* lds) {
  float* lf = (float*)lds;
  const int tid = cx.tid, k0 = kt * 64, n0 = nt * 64;
#pragma unroll
  for (int i = 0; i < 8; ++i) { int e = tid + 512 * i, kk = e >> 6, nn = e & 63; lf[kk * 65 + nn] = (n0 + nn < N) ? src[(size_t)(k0 + kk) * N + n0 + nn] : 0.f; }
  __syncthreads();
  const int nn = tid >> 3, kc = tid & 7;
  float v[8];
#pragma unroll
  for (int j = 0; j < 8; ++j) { v[j] = lf[(kc * 8 + j) * 65 + nn]; if (kscale) v[j] *= kscale[k0 + kc * 8 + j]; }
  uint4 o; o.x = pack2(v[0], v[1]); o.y = pack2(v[2], v[3]); o.z = pack2(v[4], v[5]); o.w = pack2(v[6], v[7]);
  if (n0 + nn < N) *(uint4*)(dst + (size_t)rowmap(mode, n0 + nn) * ldd + k0 + kc * 8) = o;
  __syncthreads();
}
DI void convert_mix(const Ctx cx, const Params& p, int l, char* lds) {
  const int NI = 1936 + 48 + 64 + 512 + 256 + 224;
  for (int it = cx.bid; it < NI; it += gridDim.x) {
    if (it < 1936) { convert_tile(cx, p.w_in + (size_t)l * 1024 * 7712, 7712, (bf16_t*)(p.ws + OFF_WIN), 1024, 1, nullptr, it / 121, it % 121, lds); continue; }
    int i = it - 1936;
    if (i < 48) { convert_tile(cx, p.mla_w_uq + (size_t)l * 256 * 768, 768, (bf16_t*)(p.ws + OFF_WUQ), 256, 2, p.mla_q_norm + l * 256, i / 12, i % 12, lds); continue; }
    i -= 48;
    if (i < 64) { convert_tile(cx, p.mla_w_ukv + (size_t)l * 256 * 1024, 1024, (bf16_t*)(p.ws + OFF_WUKV), 256, 3, p.mla_kv_norm + l * 256, i / 16, i % 16, lds); continue; }
    i -= 64;
    if (i < 512) { int k = i >> 7, j = i & 127; convert_tile(cx, p.w_branch + ((size_t)l * 4 + k) * 512 * 1024, 1024, (bf16_t*)(p.ws + OFF_WBR) + (size_t)k * 1024 * 512, 512, 0, nullptr, j / 16, j % 16, lds); continue; }
    i -= 512;
    if (i < 256) { convert_tile(cx, p.w_out + (size_t)l * 1024 * 1024, 1024, (bf16_t*)(p.ws + OFF_WOUT), 1024, 0, nullptr, i / 16, i % 16, lds); continue; }
    i -= 256;
    *(unsigned*)((bf16_t*)(p.ws + OFF_WIN) + (size_t)(3616 + i) * 1024 + cx.tid * 2) = 0u;
  }
}
DI void convert_ffn(const Ctx cx, const Params& p, int l, char* lds) {
  const int NI = 1408 + 704;
  for (int it = cx.bid; it < NI; it += gridDim.x) {
    if (it < 1408) { convert_tile(cx, p.ffn_w_up + (size_t)l * 1024 * 5632, 5632, (bf16_t*)(p.ws + OFF_WUP), 1024, 4, nullptr, it / 88, it % 88, lds); continue; }
    int i = it - 1408;
    convert_tile(cx, p.ffn_w_down + (size_t)l * 2816 * 1024, 1024, (bf16_t*)(p.ws + OFF_WDN), 2816, 0, nullptr, i / 16, i % 16, lds);
  }
}

DI void sincos_d(double ang, float& co, float& si) {
  const double TWO_PI = 6.283185307179586476925286766559;
  double k = rint(ang / TWO_PI);
  double r = ang - k * TWO_PI;
  double r2 = r * r, ts = r, tc = 1.0, s = r, c = 1.0;
  for (int i = 1; i <= 16; ++i) {
    tc *= -r2 / (double)((2 * i - 1) * (2 * i));
    ts *= -r2 / (double)((2 * i) * (2 * i + 1));
    c += tc; s += ts;
  }
  co = (float)c; si = (float)s;
}
DI void prep0(const Ctx cx, const Params& p, char* lds) {
  const int tid = cx.tid;
  if (cx.bid == 0 && tid < 64) ((int*)(p.ws + OFF_CTR))[tid] = 0;
  for (int idx = cx.bid * NTH + tid; idx < 128 * 16 + 128 * 8; idx += gridDim.x * NTH) {
    if (idx < 2048) {
      int pos = idx >> 4, i = idx & 15;
      double inv = 1.0; for (int j = 0; j < i; ++j) inv *= 0.5623413251903491;
      float co, si; sincos_d((double)pos * inv, co, si);
      ((float2*)(p.ws + OFF_T64))[idx] = make_float2(co, si);
    } else {
      int e = idx - 2048, pos = e >> 3, i = e & 7;
      double inv = 1.0; for (int j = 0; j < i; ++j) inv *= 0.31622776601683794;
      float co, si; sincos_d((double)pos * inv, co, si);
      ((float2*)(p.ws + OFF_T32))[e] = make_float2(co, si);
    }
  }
  float* sl = (float*)lds;
  for (int it = cx.bid; it < 192; it += gridDim.x) {
    int l = it / 96, r = it % 96, cc = r >> 3, kc = r & 7;
    __syncthreads();
    if (tid < 128) {
      int k = kc * 128 + tid;
      sl[tid] = silu_f(p.c[k]); sl[128 + tid] = silu_f(p.c[1024 + k]); sl[256 + tid] = silu_f(p.c_ctx[k]);
    }
    __syncthreads();
    const int col = cc * NTH + tid;
    const float* w = p.w_mod + ((size_t)l * 1024 + kc * 128) * 6144 + col;
    float a0 = 0.f, a1 = 0.f, a2 = 0.f;
#pragma unroll 8
    for (int k = 0; k < 128; ++k) { float wv = w[(size_t)k * 6144]; a0 += sl[k] * wv; a1 += sl[128 + k] * wv; a2 += sl[256 + k] * wv; }
    float* mp = (float*)(p.ws + OFF_MODP) + (size_t)((l * 8 + kc) * 3) * 6144 + col;
    mp[0] = a0; mp[6144] = a1; mp[2 * 6144] = a2;
  }
  __syncthreads();
  convert_mix(cx, p, 0, lds);
}

DI float mod_from_partials(const Params& p, int l, int v, int idx) {
  const float* mp = (const float*)(p.ws + OFF_MODP) + (size_t)(l * 8 * 3 + v) * 6144 + idx;
  float s = p.b_mod[l * 6144 + idx];
#pragma unroll
  for (int k = 0; k < 8; ++k) s += mp[(size_t)k * 3 * 6144];
  return s;
}
DI void norm_phase(const Ctx cx, const Params& p, int l, int which, bool from_inputs, bool partials, bool skip_ctx, char* lds) {
  const int tid = cx.tid, lane = tid & 63, wave = tid >> 6;
  float* ms = (float*)lds;
  const int sh = which ? 3 : 0;
  for (int e = tid; e < 6144; e += NTH) {
    int v = e >> 11, r = e & 2047, idx = (sh + (r >> 10)) * 1024 + (r & 1023);
    ms[e] = partials ? mod_from_partials(p, l, v, idx) : ((const float*)(p.ws + OFF_MODV))[(size_t)(l * 3 + v) * 6144 + idx];
  }
  if (partials) {
    for (int e = cx.bid * NTH + tid; e < 2 * 3 * 6144; e += gridDim.x * NTH) {
      int ll = e / (3 * 6144), r = e % (3 * 6144), v = r / 6144, idx = r % 6144;
      ((float*)(p.ws + OFF_MODV))[e] = mod_from_partials(p, ll, v, idx);
    }
  }
  __syncthreads();
  bf16_t* H = (bf16_t*)(p.ws + OFF_H);
  for (int r = cx.bid * 8 + wave; r < R; r += gridDim.x * 8) {
    const int v = variant_of(r);
    if (skip_ctx && v == 2) continue;
    const float* xr = x_row_src(p, from_inputs, r);
    float4 xv[4]; float ss = 0.f;
#pragma unroll
    for (int i = 0; i < 4; ++i) { xv[i] = *(const float4*)(xr + i * 256 + lane * 4); ss += xv[i].x * xv[i].x + xv[i].y * xv[i].y + xv[i].z * xv[i].z + xv[i].w * xv[i].w; }
    ss = wave_sum(ss);
    const float rstd = rsqrtf(ss * (1.f / 1024.f) + EPS);
    const float* shp = ms + v * 2048; const float* scp = shp + 1024;
#pragma unroll
    for (int i = 0; i < 4; ++i) {
      int c = i * 256 + lane * 4;
      float y0 = xv[i].x * rstd * (1.f + scp[c]) + shp[c], y1 = xv[i].y * rstd * (1.f + scp[c + 1]) + shp[c + 1];
      float y2 = xv[i].z * rstd * (1.f + scp[c + 2]) + shp[c + 2], y3 = xv[i].w * rstd * (1.f + scp[c + 3]) + shp[c + 3];
      uint2 o; o.x = pack2(y0, y1); o.y = pack2(y2, y3);
      *(uint2*)(H + (size_t)r * 1024 + c) = o;
    }
  }
  __syncthreads();
}

struct TokInfo { int r, b, pp, trow, tcol; bool is_main; };
DI TokInfo tok_info(int r) { TokInfo t; t.r = r; t.b = r >= RB ? 1 : 0; t.pp = r - t.b * RB; t.is_main = t.pp >= NCTX; int n = t.pp - NCTX; t.trow = (n >> 6) & 127; t.tcol = n & 63; return t; }

DI void epi_qk64(const f32x16& a0, const f32x16& a1, const TokInfo& t, int h, const float* __restrict__ gain, bool rope, float scale,
                 bf16_t* __restrict__ dst, int ld, int col, const float2* __restrict__ T64) {
  float v[2][16];
#pragma unroll
  for (int i = 0; i < 16; ++i) { v[0][i] = a0[i]; v[1][i] = a1[i]; }
  if (gain) {
    float ss = 0.f;
#pragma unroll
    for (int i = 0; i < 16; ++i) ss += v[0][i] * v[0][i] + v[1][i] * v[1][i];
    ss = swap_sum(ss);
    const float rstd = rsqrtf(ss * (1.f / 64.f) + EPS);
#pragma unroll
    for (int fi = 0; fi < 2; ++fi)
#pragma unroll
      for (int i = 0; i < 16; ++i) v[fi][i] *= rstd * gain[fi * 32 + 8 * (i >> 2) + 4 * h + (i & 3)];
  }
  if (rope && t.is_main) {
#pragma unroll
    for (int fi = 0; fi < 2; ++fi) {
      const float2* tb = T64 + (fi == 0 ? t.trow : t.tcol) * 16;
#pragma unroll
      for (int g = 0; g < 4; ++g)
#pragma unroll
        for (int jj = 0; jj < 2; ++jj) {
          float2 cs = tb[4 * g + 2 * h + jj];
          float x0 = v[fi][4 * g + 2 * jj], x1 = v[fi][4 * g + 2 * jj + 1];
          v[fi][4 * g + 2 * jj] = x0 * cs.x - x1 * cs.y;
          v[fi][4 * g + 2 * jj + 1] = x0 * cs.y + x1 * cs.x;
        }
    }
  }
  bf16_t* d = dst + (size_t)t.r * ld + col + 4 * h;
#pragma unroll
  for (int fi = 0; fi < 2; ++fi)
#pragma unroll
    for (int g = 0; g < 4; ++g) {
      uint2 o; o.x = pack2(v[fi][4 * g] * scale, v[fi][4 * g + 1] * scale); o.y = pack2(v[fi][4 * g + 2] * scale, v[fi][4 * g + 3] * scale);
      *(uint2*)(d + fi * 32 + 8 * g) = o;
    }
}
DI void epi_vt(const f32x16& a0, const f32x16& a1, const TokInfo& t, int h, bf16_t* __restrict__ VT, int nh, int head, int dv, int d0, float scale) {
  bf16_t* d = VT + ((size_t)(t.b * nh + head) * dv + d0 + 4 * h) * RB + t.pp;
#pragma unroll
  for (int i = 0; i < 16; ++i) {
    int f = 8 * (i >> 2) + (i & 3);
    d[(size_t)f * RB] = (bf16_t)(pack2(a0[i] * scale, 0.f) & 0xffff);
    d[(size_t)(32 + f) * RB] = (bf16_t)(pack2(a1[i] * scale, 0.f) & 0xffff);
  }
}
DI void epi_plain(const f32x16& a0, const f32x16& a1, const TokInfo& t, int h, bf16_t* __restrict__ dst, int ld, int col, float scale) {
  bf16_t* d = dst + (size_t)t.r * ld + col + 4 * h;
#pragma unroll
  for (int g = 0; g < 4; ++g) {
    uint2 o; o.x = pack2(a0[4 * g] * scale, a0[4 * g + 1] * scale); o.y = pack2(a0[4 * g + 2] * scale, a0[4 * g + 3] * scale);
    *(uint2*)(d + 8 * g) = o;
    uint2 q; q.x = pack2(a1[4 * g] * scale, a1[4 * g + 1] * scale); q.y = pack2(a1[4 * g + 2] * scale, a1[4 * g + 3] * scale);
    *(uint2*)(d + 32 + 8 * g) = q;
  }
}

DI void gemm_in_phase(const Ctx cx, const Params& p, int l, char* lds, int skip_epi = 0) {
  const int tid = cx.tid, lane = tid & 63, wave = tid >> 6, wm = wave >> 2, wn = wave & 3, l31 = lane & 31, h = lane >> 5;
  const bf16_t* W = (const bf16_t*)(p.ws + OFF_WIN);
  const bf16_t* H = (const bf16_t*)(p.ws + OFF_H);
  const float2* T64 = (const float2*)(p.ws + OFF_T64);
  const float2* T32 = (const float2*)(p.ws + OFF_T32);
  const float qs64 = 0.125f * LOG2E;
  XCD_ITEMS_BEGIN(66, 15)
    const int tt = tti;
    f32x16 acc[4][2]; zero_acc<4>(acc);
    gemm_core<4>(cx, W + (size_t)ft * 256 * 1024, 1024, H, 1024, tt * 256, 0, R - 1, 1024, acc, lds);
    if (skip_epi) { if (acc[0][0][0] == 12345.678f && acc[1][1][3] == 1.f && acc[2][0][5] == 2.f && acc[3][1][7] == 3.f) ((float*)(p.ws + OFF_CTR))[40] = 1.f; continue; }
#pragma unroll
    for (int gi = 0; gi < 2; ++gi) {
    const int fb = ft * 256 + wm * 128 + gi * 64;
#pragma unroll
    for (int ti = 0; ti < 2; ++ti) {
      const TokInfo t = tok_info(tt * 256 + wn * 64 + ti * 32 + l31);
      const f32x16& a0 = acc[2 * gi][ti]; const f32x16& a1 = acc[2 * gi + 1][ti];
      if (fb < 512) epi_qk64(a0, a1, t, h, nullptr, true, qs64, (bf16_t*)(p.ws + OFF_QA), 512, fb, T64);
      else if (fb < 1024) epi_qk64(a0, a1, t, h, nullptr, true, 1.f, (bf16_t*)(p.ws + OFF_KA), 512, fb - 512, T64);
      else if (fb < 1536) epi_vt(a0, a1, t, h, (bf16_t*)(p.ws + OFF_VA), 4, (fb - 1024) >> 7, 128, (fb - 1024) & 127, 1.f);
      else if (fb < 2048) epi_qk64(a0, a1, t, h, p.gqa_q_norm + l * 64, true, qs64, (bf16_t*)(p.ws + OFF_QC), 512, fb - 1536, T64);
      else if (fb < 2176) epi_qk64(a0, a1, t, h, p.gqa_k_norm + l * 64, true, 1.f, (bf16_t*)(p.ws + OFF_KC), 128, fb - 2048, T64);
      else if (fb < 2304) epi_vt(a0, a1, t, h, (bf16_t*)(p.ws + OFF_VC), 2, (fb - 2176) >> 6, 64, 0, 1.f);
      else if (fb < 2816) epi_qk64(a0, a1, t, h, nullptr, true, qs64, (bf16_t*)(p.ws + OFF_QD), 512, fb - 2304, T64);
      else if (fb < 2944) epi_qk64(a0, a1, t, h, nullptr, true, 1.f, (bf16_t*)(p.ws + OFF_KD), 128, fb - 2816, T64);
      else if (fb < 3072) epi_vt(a0, a1, t, h, (bf16_t*)(p.ws + OFF_VD), 2, (fb - 2944) >> 6, 64, 0, 1.f);
      else if (fb < 3328) epi_plain(a0, a1, t, h, (bf16_t*)(p.ws + OFF_OB), 256, fb - 3072, 1.f);
      else if (fb < 3584) epi_plain(a0, a1, t, h, (bf16_t*)(p.ws + OFF_OB) + (size_t)R * 256, 256, fb - 3328, 1.f);
      else if (fb < 3648) {
        float v[16];
#pragma unroll
        for (int i = 0; i < 16; ++i) v[i] = a0[i];
        if (t.is_main) {
#pragma unroll
          for (int g = 0; g < 4; ++g)
#pragma unroll
            for (int jj = 0; jj < 2; ++jj) {
              float2 cs = g < 2 ? T32[t.trow * 8 + 4 * g + 2 * h + jj] : T32[t.tcol * 8 + 4 * (g - 2) + 2 * h + jj];
              float x0 = v[4 * g + 2 * jj], x1 = v[4 * g + 2 * jj + 1];
              v[4 * g + 2 * jj] = x0 * cs.x - x1 * cs.y; v[4 * g + 2 * jj + 1] = x0 * cs.y + x1 * cs.x;
            }
        }
        bf16_t* d = (bf16_t*)(p.ws + OFF_KB) + (size_t)t.r * 768 + 64 + 4 * h;
#pragma unroll
        for (int g = 0; g < 4; ++g) {
          uint2 o; o.x = pack2(v[4 * g], v[4 * g + 1]); o.y = pack2(v[4 * g + 2], v[4 * g + 3]);
#pragma unroll
          for (int hd = 0; hd < 8; ++hd) *(uint2*)(d + hd * 96 + 8 * g) = o;
        }
      }
    }
    }
  XCD_ITEMS_END
}

DI void gemm_mla_phase(const Ctx cx, const Params& p, char* lds) {
  const int tid = cx.tid, lane = tid & 63, wave = tid >> 6, wm = wave >> 2, wn = wave & 3, l31 = lane & 31, h = lane >> 5;
  const float2* T32 = (const float2*)(p.ws + OFF_T32);
  float* rs = (float*)(lds + LDS_MISC);
  const float qs96 = 0.10206207261596577f * LOG2E;
  XCD_ITEMS_BEGIN(66, 7)
    const int tt = tti, fti = ft;
    const bool isq = fti < 3;
    const int ft2 = isq ? fti : fti - 3;
    const bf16_t* X = (const bf16_t*)(p.ws + OFF_OB) + (isq ? 0 : (size_t)R * 256);
    const bf16_t* W = (const bf16_t*)(p.ws + (isq ? OFF_WUQ : OFF_WUKV)) + (size_t)ft2 * 256 * 256;
    {
      const int row = tid >> 1, half = tid & 1;
      const bf16_t* xr = X + (size_t)(tt * 256 + row) * 256 + half * 128;
      float ss = 0.f;
#pragma unroll
      for (int i = 0; i < 16; ++i) {
        uint4 u = *(const uint4*)(xr + i * 8);
        unsigned w4[4] = {u.x, u.y, u.z, u.w};
#pragma unroll
        for (int j = 0; j < 4; ++j) { float a = __uint_as_float(w4[j] << 16), b = __uint_as_float(w4[j] & 0xffff0000u); ss += a * a + b * b; }
      }
      ss += __shfl_xor(ss, 1);
      if (half == 0) rs[row] = rsqrtf(ss * (1.f / 256.f) + EPS);
    }
    f32x16 acc[4][2]; zero_acc<4>(acc);
    gemm_core<4>(cx, W, 256, X, 256, tt * 256, 0, R - 1, 256, acc, lds);
#pragma unroll
    for (int gi = 0; gi < 2; ++gi) {
    const int fb = ft2 * 256 + wm * 128 + gi * 64;
#pragma unroll
    for (int ti = 0; ti < 2; ++ti) {
      const int tl = wn * 64 + ti * 32 + l31;
      const TokInfo t = tok_info(tt * 256 + tl);
      const float rstd = rs[tl];
      const f32x16& a0 = acc[2 * gi][ti]; const f32x16& a1 = acc[2 * gi + 1][ti];
      if (isq) {
        if (fb < 512) epi_plain(a0, a1, t, h, (bf16_t*)(p.ws + OFF_QB), 768, (fb >> 6) * 96, rstd * qs96);
        else {
#pragma unroll
          for (int fi = 0; fi < 2; ++fi) {
            const int head = ((fb - 512) >> 5) + fi;
            float v[16];
#pragma unroll
            for (int i = 0; i < 16; ++i) v[i] = (fi == 0 ? a0[i] : a1[i]) * (rstd * qs96);
            if (t.is_main) {
#pragma unroll
              for (int g = 0; g < 4; ++g)
#pragma unroll
                for (int jj = 0; jj < 2; ++jj) {
                  float2 cs = g < 2 ? T32[t.trow * 8 + 4 * g + 2 * h + jj] : T32[t.tcol * 8 + 4 * (g - 2) + 2 * h + jj];
                  float x0 = v[4 * g + 2 * jj], x1 = v[4 * g + 2 * jj + 1];
                  v[4 * g + 2 * jj] = x0 * cs.x - x1 * cs.y; v[4 * g + 2 * jj + 1] = x0 * cs.y + x1 * cs.x;
                }
            }
            bf16_t* d = (bf16_t*)(p.ws + OFF_QB) + (size_t)t.r * 768 + head * 96 + 64 + 4 * h;
#pragma unroll
            for (int g = 0; g < 4; ++g) { uint2 o; o.x = pack2(v[4 * g], v[4 * g + 1]); o.y = pack2(v[4 * g + 2], v[4 * g + 3]); *(uint2*)(d + 8 * g) = o; }
          }
        }
      } else {
        if (fb < 512) epi_plain(a0, a1, t, h, (bf16_t*)(p.ws + OFF_KB), 768, (fb >> 6) * 96, rstd);
        else epi_vt(a0, a1, t, h, (bf16_t*)(p.ws + OFF_VB), 8, (fb - 512) >> 6, 64, 0, rstd);
      }
    }
    }
    __syncthreads();
  XCD_ITEMS_END
}

template <int DQK, int DV, bool WINDOW>
DI void attn_core(const Ctx cx, const bf16x8 (&qf)[DQK / 16], const bf16_t* __restrict__ Kb, int ldk, const bf16_t* __restrict__ VT,
                  int n_a, int t_b0, int n_b, int qpos, float& m, float& l, f32x16 (&O)[DV / 32], char* lds) {
  constexpr int KST = DQK * 2 + 16, VST = 136, CPR = DQK / 8, NS = DQK / 16, NO = DV / 32;
  constexpr int KBUF = 64 * KST, VBASE = 2 * KBUF, VBUF = DV * VST;
  const int tid = cx.tid, lane = tid & 63, l31 = lane & 31, h = lane >> 5;
  const int krow0 = tid / CPR, kch0 = tid - krow0 * CPR;
  const int krow1 = (tid + 512) / CPR, kch1 = (tid + 512) - krow1 * CPR;
  const bool k2 = (CPR == 12) && (tid < 256);
  const int vrow0 = tid >> 3, vch = tid & 7;
  uint4 rk0, rk1 = make_uint4(0, 0, 0, 0), rv0, rv1 = make_uint4(0, 0, 0, 0);
  const int nt = n_a + n_b;
  const int tb_adj = t_b0 - n_a;
  auto tile_of = [=](int it) { return it < n_a ? it : tb_adj + it; };
#define GLOAD(tile_) do { const int tl_ = (tile_); \
    rk0 = *(const uint4*)(Kb + (size_t)(tl_ * 64 + krow0) * ldk + kch0 * 8); \
    if (k2) rk1 = *(const uint4*)(Kb + (size_t)(tl_ * 64 + krow1) * ldk + kch1 * 8); \
    rv0 = *(const uint4*)(VT + (size_t)(vrow0) * RB + tl_ * 64 + vch * 8); \
    if (DV > 64) rv1 = *(const uint4*)(VT + (size_t)(vrow0 + 64) * RB + tl_ * 64 + vch * 8); } while (0)
#define VSTORE_(rv_, c_) do { char* d_ = lds + VBASE + bb_ * VBUF + (vrow0 + 64 * (c_)) * VST + vch * 16; \
      *(uint2*)d_ = make_uint2(rv_.x, rv_.y); *(uint2*)(d_ + 8) = make_uint2(rv_.z, rv_.w); } while (0)
#define LSTORE(b_) do { const int bb_ = (b_); \
    *(uint4*)(lds + bb_ * KBUF + krow0 * KST + kch0 * 16) = rk0; \
    if (k2) *(uint4*)(lds + bb_ * KBUF + krow1 * KST + kch1 * 16) = rk1; \
    VSTORE_(rv0, 0); if (DV > 64) VSTORE_(rv1, 1); } while (0)
  f32x16 negm, Lacc;
#pragma unroll
  for (int i = 0; i < 16; ++i) { negm[i] = -m; Lacc[i] = l; }
  bf16x8 ones;
#pragma unroll
  for (int i = 0; i < 8; ++i) ones[i] = (short)0x3F80;
  GLOAD(tile_of(0)); LSTORE(0);
  __syncthreads();
  for (int it = 0; it < nt; ++it) {
    const int cur = it & 1;
    const bool more = it + 1 < nt;
    if (more) GLOAD(tile_of(it + 1));
    f32x16 s0, s1;
    const char* kb = lds + cur * KBUF + l31 * KST + h * 16;
    {
      bf16x8 k0 = *(const bf16x8*)(kb), k1 = *(const bf16x8*)(kb + 32 * KST);
      s0 = MFMA(k0, qf[0], negm); s1 = MFMA(k1, qf[0], negm);
    }
#pragma unroll
    for (int s = 1; s < NS; ++s) {
      bf16x8 k0 = *(const bf16x8*)(kb + s * 32), k1 = *(const bf16x8*)(kb + 32 * KST + s * 32);
      s0 = MFMA(k0, qf[s], s0); s1 = MFMA(k1, qf[s], s1);
    }
    if (WINDOW) {
      const int tile = tile_of(it);
      if (tile >= 4) {
        const int kp0 = tile * 64 - NCTX + 4 * h - qpos;
#pragma unroll
        for (int i = 0; i < 16; ++i) {
          int d0 = kp0 + 8 * (i >> 2) + (i & 3), d1 = d0 + 32;
          if (d0 > 128 || d0 < -128) s0[i] = -1e30f;
          if (d1 > 128 || d1 < -128) s1[i] = -1e30f;
        }
      }
    }
    int im = max(__float_as_int(s0[0]), __float_as_int(s1[0]));
#pragma unroll
    for (int i = 1; i < 16; ++i) im = max(im, max(__float_as_int(s0[i]), __float_as_int(s1[i])));
    const bool force = (!WINDOW) && (it == 0);
    if (force || __any(im > 0x41000000)) {
      float tmax = fmaxf(s0[0], s1[0]);
#pragma unroll
      for (int i = 1; i < 16; ++i) tmax = fmaxf(tmax, fmaxf(s0[i], s1[i]));
      tmax = swap_max(tmax);
      const float d = force ? tmax : fmaxf(tmax, 0.f);
      m += d;
#pragma unroll
      for (int i = 0; i < 16; ++i) negm[i] = -m;
      if (!force) {
        const float alpha = __builtin_amdgcn_exp2f(-d);
#pragma unroll
        for (int i = 0; i < 16; ++i) Lacc[i] *= alpha;
#pragma unroll
        for (int o = 0; o < NO; ++o)
#pragma unroll
          for (int i = 0; i < 16; ++i) O[o][i] *= alpha;
      }
#pragma unroll
      for (int i = 0; i < 16; ++i) { s0[i] -= d; s1[i] -= d; }
    }
#pragma unroll
    for (int i = 0; i < 16; ++i) { s0[i] = __builtin_amdgcn_exp2f(s0[i]); s1[i] = __builtin_amdgcn_exp2f(s1[i]); }
    const char* vb = lds + VBASE + cur * VBUF + l31 * VST + h * 8;
#pragma unroll
    for (int mt = 0; mt < 2; ++mt)
#pragma unroll
      for (int s2 = 0; s2 < 2; ++s2) {
        const f32x16& sv = mt == 0 ? s0 : s1;
        unsigned pw[4];
#pragma unroll
        for (int j = 0; j < 4; ++j) pw[j] = pack2(sv[8 * s2 + 2 * j], sv[8 * s2 + 2 * j + 1]);
        bf16x8 pf = __builtin_bit_cast(bf16x8, make_uint4(pw[0], pw[1], pw[2], pw[3]));
        const int ko = (32 * mt + 16 * s2) * 2;
        Lacc = MFMA(ones, pf, Lacc);
#pragma unroll
        for (int o = 0; o < NO; ++o) {
          s16x4 lo = *(const s16x4*)(vb + o * 32 * VST + ko), hi = *(const s16x4*)(vb + o * 32 * VST + ko + 16);
          bf16x8 vf = __builtin_shufflevector(lo, hi, 0, 1, 2, 3, 4, 5, 6, 7);
          O[o] = MFMA(vf, pf, O[o]);
        }
      }
    if (more) LSTORE(cur ^ 1);
    __syncthreads();
  }
  l = Lacc[0];
}

template <int NS>
DI void load_q(bf16x8 (&qf)[NS], const bf16_t* __restrict__ qptr, int h) {
#pragma unroll
  for (int s = 0; s < NS; ++s) qf[s] = *(const bf16x8*)(qptr + 16 * s + 8 * h);
}
template <int NO>
DI void store_o(const f32x16 (&O)[NO], bf16_t* __restrict__ d, int h) {
#pragma unroll
  for (int o = 0; o < NO; ++o)
#pragma unroll
    for (int g = 0; g < 4; ++g) {
      uint2 w; w.x = pack2(O[o][4 * g], O[o][4 * g + 1]); w.y = pack2(O[o][4 * g + 2], O[o][4 * g + 3]);
      *(uint2*)(d + o * 32 + 8 * g + 4 * h) = w;
    }
}

DI void attn_phase(const Ctx cx0, const Params& p, int l, int slot, char* lds) {
  const int xcd = cx0.bid & 7;
  int* ctr = (int*)(p.ws + OFF_CTR) + slot * 8 + xcd;
  int* sh_item = (int*)(lds + LDS_MISC + 1024);
  const int NITEMS = (l == 0) ? 224 + 7 : 224;
  const float lam_init = 0.8f - 0.6f * __expf(-0.3f * (float)l);
  for (;;) {
    Ctx cx = cx0;
    asm volatile("" : "+v"(cx.tid));
    const int tid = cx.tid, lane = tid & 63, wave = tid >> 6, l31 = lane & 31, h = lane >> 5;
    if (tid == 0) *sh_item = atomicAdd(ctr, 1);
    __syncthreads();
    const int item = *sh_item;
    __syncthreads();
    if (item >= NITEMS) break;
    int br, b, head, qt; bool isctx = false;
    if (item < 32) { br = 0; b = xcd >> 2; head = xcd & 3; qt = item; }
    else if (item < 224) { int i = item - 32; br = 1 + (i >> 6); i &= 63; const int g = xcd + 8 * (i >> 5); b = g >> 3; head = g & 7; qt = i & 31; }
    else {
      isctx = true; qt = 0; int i = xcd * 7 + (item - 224);
      if (i < 8) { br = 0; b = i >> 2; head = i & 3; }
      else { i -= 8; br = 1 + (i >> 4); i &= 15; b = i >> 3; head = i & 7; }
    }
    const int r0 = b * RB + (isctx ? 0 : NCTX + qt * 256);
    const int rq = r0 + wave * 32 + l31;
    const int nka = isctx ? 4 : 132;
    if (br == 0) {
      const float* lv = p.diff_lambda + l * 256;
      float d1 = lv[lane] * lv[64 + lane], d2 = lv[128 + lane] * lv[192 + lane];
      d1 = wave_sum(d1); d2 = wave_sum(d2);
      const float lam = __expf(d1) - __expf(d2) + lam_init;
      const bf16_t* VT = (const bf16_t*)(p.ws + OFF_VA) + (size_t)(b * 4 + head) * 128 * RB;
      f32x16 O1[4];
#pragma unroll
      for (int o = 0; o < 4; ++o)
#pragma unroll
        for (int i = 0; i < 16; ++i) O1[o][i] = 0.f;
      float m1 = -100.f, l1 = 0.f, m2 = -100.f, l2 = 0.f;
      bf16_t* slot = (bf16_t*)(p.ws + OFF_QA) + (size_t)rq * 512 + head * 128;
      bf16x8 qa[4], qb[4];
      load_q<4>(qa, slot, h); load_q<4>(qb, slot + 64, h);
      attn_core<64, 128, false>(cx, qa, (const bf16_t*)(p.ws + OFF_KA) + (size_t)b * RB * 512 + (2 * head) * 64, 512, VT, nka, 0, 0, 0, m1, l1, O1, lds);
      const float i1 = 1.f / l1;
#pragma unroll
      for (int o = 0; o < 4; ++o)
#pragma unroll
        for (int i = 0; i < 16; ++i) O1[o][i] *= i1;
      store_o<4>(O1, slot, h);
#pragma unroll
      for (int o = 0; o < 4; ++o)
#pragma unroll
        for (int i = 0; i < 16; ++i) O1[o][i] = 0.f;
      attn_core<64, 128, false>(cx, qb, (const bf16_t*)(p.ws + OFF_KA) + (size_t)b * RB * 512 + (2 * head + 1) * 64, 512, VT, nka, 0, 0, 0, m2, l2, O1, lds);
      const float i2 = lam / l2;
      float ss = 0.f;
#pragma unroll
      for (int o = 0; o < 4; ++o)
#pragma unroll
        for (int g = 0; g < 4; ++g) {
          uint2 w = *(const uint2*)(slot + o * 32 + 8 * g + 4 * h);
          float a0 = __uint_as_float(w.x << 16) - O1[o][4 * g] * i2, a1 = __uint_as_float(w.x & 0xffff0000u) - O1[o][4 * g + 1] * i2;
          float a2 = __uint_as_float(w.y << 16) - O1[o][4 * g + 2] * i2, a3 = __uint_as_float(w.y & 0xffff0000u) - O1[o][4 * g + 3] * i2;
          O1[o][4 * g] = a0; O1[o][4 * g + 1] = a1; O1[o][4 * g + 2] = a2; O1[o][4 * g + 3] = a3;
          ss += a0 * a0 + a1 * a1 + a2 * a2 + a3 * a3;
        }
      ss = swap_sum(ss);
      const float rstd = rsqrtf(ss * (1.f / 128.f) + EPS) * (1.f - lam_init);
      const float* sg = p.diff_subln + l * 128;
#pragma unroll
      for (int o = 0; o < 4; ++o)
#pragma unroll
        for (int i = 0; i < 16; ++i) O1[o][i] *= rstd * sg[o * 32 + 8 * (i >> 2) + 4 * h + (i & 3)];
      store_o<4>(O1, (bf16_t*)(p.ws + OFF_QA) + (size_t)rq * 512 + head * 128, h);
    } else if (br == 1) {
      f32x16 O[2];
#pragma unroll
      for (int o = 0; o < 2; ++o)
#pragma unroll
        for (int i = 0; i < 16; ++i) O[o][i] = 0.f;
      float m = -100.f, ls = 0.f;
      bf16x8 qf[6]; load_q<6>(qf, (const bf16_t*)(p.ws + OFF_QB) + (size_t)rq * 768 + head * 96, h);
      attn_core<96, 64, false>(cx, qf,
                               (const bf16_t*)(p.ws + OFF_KB) + (size_t)b * RB * 768 + head * 96, 768,
                               (const bf16_t*)(p.ws + OFF_VB) + (size_t)(b * 8 + head) * 64 * RB, nka, 0, 0, 0, m, ls, O, lds);
      const float inv = 1.f / ls;
#pragma unroll
      for (int o = 0; o < 2; ++o)
#pragma unroll
        for (int i = 0; i < 16; ++i) O[o][i] *= inv;
      store_o<2>(O, (bf16_t*)(p.ws + OFF_OB) + (size_t)rq * 512 + head * 64, h);
    } else if (br == 2) {
      f32x16 O[2];
#pragma unroll
      for (int o = 0; o < 2; ++o)
#pragma unroll
        for (int i = 0; i < 16; ++i) O[o][i] = 0.f;
      float m = -100.f, ls = 0.f;
      const int kvh = head >> 2;
      bf16x8 qf[4]; load_q<4>(qf, (const bf16_t*)(p.ws + OFF_QC) + (size_t)rq * 512 + head * 64, h);
      attn_core<64, 64, false>(cx, qf,
                               (const bf16_t*)(p.ws + OFF_KC) + (size_t)b * RB * 128 + kvh * 64, 128,
                               (const bf16_t*)(p.ws + OFF_VC) + (size_t)(b * 2 + kvh) * 64 * RB, nka, 0, 0, 0, m, ls, O, lds);
      const float inv = 1.f / ls;
#pragma unroll
      for (int o = 0; o < 2; ++o)
#pragma unroll
        for (int i = 0; i < 16; ++i) O[o][i] *= inv;
      store_o<2>(O, (bf16_t*)(p.ws + OFF_QC) + (size_t)rq * 512 + head * 64, h);
    } else {
      f32x16 O[2];
#pragma unroll
      for (int o = 0; o < 2; ++o)
#pragma unroll
        for (int i = 0; i < 16; ++i) O[o][i] = 0.f;
      float m = p.swa_sink[l * 8 + head] * LOG2E, ls = 1.f;
      const int kvh = head >> 2;
      int tb0 = 0, nb = 0;
      if (!isctx) {
        int lo = max(2 * qt - 1, 0) * 128, hi = min(2 * qt + 3, 64) * 128;
        tb0 = 4 + (lo >> 6); nb = (hi - lo) >> 6;
      }
      bf16x8 qf[4]; load_q<4>(qf, (const bf16_t*)(p.ws + OFF_QD) + (size_t)rq * 512 + head * 64, h);
      attn_core<64, 64, true>(cx, qf,
                              (const bf16_t*)(p.ws + OFF_KD) + (size_t)b * RB * 128 + kvh * 64, 128,
                              (const bf16_t*)(p.ws + OFF_VD) + (size_t)(b * 2 + kvh) * 64 * RB, 4, tb0, nb, qt * 256 + wave * 32 + l31, m, ls, O, lds);
      const float inv = 1.f / ls;
#pragma unroll
      for (int o = 0; o < 2; ++o)
#pragma unroll
        for (int i = 0; i < 16; ++i) O[o][i] *= inv;
      store_o<2>(O, (bf16_t*)(p.ws + OFF_QD) + (size_t)rq * 512 + head * 64, h);
    }
  }
}

template <int MF>
DI void stage_tile(const Ctx cx, const f32x16 (&acc)[MF][2], float* U, int fbase_sub) {
  const int tid = cx.tid, lane = tid & 63, wave = tid >> 6, wn = wave & 3, l31 = lane & 31, h = lane >> 5;
#pragma unroll
  for (int ti = 0; ti < 2; ++ti)
#pragma unroll
    for (int fi = 0; fi < MF; ++fi)
#pragma unroll
      for (int g = 0; g < 4; ++g) {
        const int tokl = wn * 64 + ti * 32 + l31, fl = fbase_sub + fi * 32 + 8 * g + 4 * h;
        *(float4*)(U + tokl * 132 + fl) = make_float4(acc[fi][ti][4 * g], acc[fi][ti][4 * g + 1], acc[fi][ti][4 * g + 2], acc[fi][ti][4 * g + 3]);
      }
}
DI void merge_phase(const Ctx cx, const Params& p, int l, char* lds) {
  const int tid = cx.tid, wave = tid >> 6, wm = wave >> 2;
  const int fc = tid & 31, tr = tid >> 5;
  const bf16_t* H = (const bf16_t*)(p.ws + OFF_H);
  float* U = (float*)lds;
  const int ntt = l == 0 ? 66 : 64;
  XCD_ITEMS_BEGIN(ntt, 8)
    const int tt = tt_of(l, tti);
    float4 tot[16];
#pragma unroll
    for (int i = 0; i < 16; ++i) tot[i] = make_float4(0.f, 0.f, 0.f, 0.f);
#pragma unroll 1
    for (int k = 0; k < 4; ++k) {
      bf16_t* Mrow = (bf16_t*)(p.ws + OFF_M) + (size_t)(tt * 256 + tr) * 1024 + ft * 128 + 4 * fc;
      {
        f32x16 acc[2][2]; zero_acc<2>(acc);
        gemm_core<2>(cx, (const bf16_t*)(p.ws + OFF_WIN) + (size_t)(3840 + k * 1024 + ft * 128) * 1024, 1024, H, 1024, tt * 256, 0, R - 1, 1024, acc, lds);
        stage_tile<2>(cx, acc, U, wm * 64);
      }
      __syncthreads();
#pragma unroll
      for (int i = 0; i < 16; ++i) {
        const float4 u = *(const float4*)(U + (i * 16 + tr) * 132 + 4 * fc);
        uint2 g; g.x = pack2(sigmoid_f(u.x), sigmoid_f(u.y)); g.y = pack2(sigmoid_f(u.z), sigmoid_f(u.w));
        *(uint2*)(Mrow + (size_t)i * 16 * 1024) = g;
      }
      __syncthreads();
      {
        f32x16 acc[2][2]; zero_acc<2>(acc);
        const size_t xo = k == 0 ? OFF_QA : (k == 1 ? OFF_OB : (k == 2 ? OFF_QC : OFF_QD));
        gemm_core<2>(cx, (const bf16_t*)(p.ws + OFF_WBR) + (size_t)(k * 1024 + ft * 128) * 512, 512, (const bf16_t*)(p.ws + xo), 512, tt * 256, 0, R - 1, 512, acc, lds);
        stage_tile<2>(cx, acc, U, wm * 64);
      }
      __syncthreads();
#pragma unroll
      for (int i = 0; i < 16; ++i) {
        const float4 u = *(const float4*)(U + (i * 16 + tr) * 132 + 4 * fc);
        const uint2 g = *(const uint2*)(Mrow + (size_t)i * 16 * 1024);
        tot[i].x += __uint_as_float(g.x << 16) * u.x; tot[i].y += __uint_as_float(g.x & 0xffff0000u) * u.y;
        tot[i].z += __uint_as_float(g.y << 16) * u.z; tot[i].w += __uint_as_float(g.y & 0xffff0000u) * u.w;
      }
      __syncthreads();
    }
    bf16_t* M = (bf16_t*)(p.ws + OFF_M);
#pragma unroll
    for (int i = 0; i < 16; ++i) {
      uint2 o; o.x = pack2(tot[i].x, tot[i].y); o.y = pack2(tot[i].z, tot[i].w);
      *(uint2*)(M + (size_t)(tt * 256 + i * 16 + tr) * 1024 + ft * 128 + 4 * fc) = o;
    }
  XCD_ITEMS_END
}

template <int MF>
DI void resid_item(const Ctx cx, const Params& p, const float* modv, const bf16_t* W, int K, const bf16_t* X, bool from_inputs, int tt, int fbase, char* lds, int skip_epi) {
  constexpr int FH = MF == 4 ? 2 : 1, FW = MF == 4 ? 128 : 64 * MF;
  constexpr int LPR = FW / 4, RPP = 512 / LPR, NP = 256 / RPP;
  const int tid = cx.tid, wave = tid >> 6, wm = wave >> 2;
  const int fc = tid & (LPR - 1), tr = tid / LPR;
  float* U = (float*)lds;
  f32x16 acc[MF][2]; zero_acc<MF>(acc);
  gemm_core<MF>(cx, W + (size_t)fbase * K, K, X, K, tt * 256, 0, R - 1, K, acc, lds);
  if (skip_epi) { if (acc[0][0][0] == 12345.678f && acc[0][1][3] == 1.f) ((float*)(p.ws + OFF_CTR))[40] = 1.f; return; }
  const float* mv = modv + variant_of(tt * 256) * 6144;
#pragma unroll 1
  for (int fh = 0; fh < FH; ++fh) {
    if (MF == 4) { if (wm == fh) stage_tile<MF>(cx, acc, U, 0); }
    else stage_tile<MF>(cx, acc, U, wm * 32 * MF);
    __syncthreads();
    const int f = fbase + fh * 128 + 4 * fc;
    const float4 mm = *(const float4*)(mv + f);
    const float* xs0 = x_row_src(p, from_inputs, tt * 256) + (size_t)tr * 1024 + f;
    float* xd0 = x_row_dst(p, tt * 256) + (size_t)tr * 1024 + f;
    const float* up = U + tr * 132 + 4 * fc;
#pragma unroll 1
    for (int i4 = 0; i4 < NP / 4; ++i4) {
      float4 xo[4];
#pragma unroll
      for (int j = 0; j < 4; ++j) xo[j] = *(const float4*)(xs0 + (size_t)(i4 * 4 + j) * RPP * 1024);
#pragma unroll
      for (int j = 0; j < 4; ++j) {
        const float4 u = *(const float4*)(up + (i4 * 4 + j) * RPP * 132);
        float4 o = xo[j];
        o.x += mm.x * u.x; o.y += mm.y * u.y; o.z += mm.z * u.z; o.w += mm.w * u.w;
        { float* xq_ = xd0 + (size_t)(i4 * 4 + j) * RPP * 1024; __builtin_nontemporal_store(o.x, xq_); __builtin_nontemporal_store(o.y, xq_ + 1); __builtin_nontemporal_store(o.z, xq_ + 2); __builtin_nontemporal_store(o.w, xq_ + 3); }
      }
    }
    __syncthreads();
  }
}
DI void resid_gemm_phase(const Ctx cx, const Params& p, int l, const bf16_t* W, int K, const bf16_t* X, int midx, bool from_inputs, char* lds, int skip_epi = 0) {
  const float* modv = (const float*)(p.ws + OFF_MODV) + (size_t)l * 3 * 6144 + midx * 1024;
  XCD_ITEMS_BEGIN(64, 4)
    resid_item<4>(cx, p, modv, W, K, X, from_inputs, tt_of(1, tti), ft * 256, lds, skip_epi);
  XCD_ITEMS_END
  if (l == 0)
    for (int q = cx.bid; q < 32; q += (int)gridDim.x) resid_item<1>(cx, p, modv, W, K, X, from_inputs, (q >> 4) ? 33 : 0, (q & 15) * 64, lds, skip_epi);
}

DI void ffn_up_phase(const Ctx cx, const Params& p, int l, char* lds) {
  const int tid = cx.tid, lane = tid & 63, wave = tid >> 6, wm = wave >> 2, wn = wave & 3, l31 = lane & 31, h = lane >> 5;
  const bf16_t* H = (const bf16_t*)(p.ws + OFF_H);
  const bf16_t* W = (const bf16_t*)(p.ws + OFF_WUP);
  bf16_t* ACT = (bf16_t*)(p.ws + OFF_ACT);
  float* U = (float*)lds;
  const int ntk = l == 0 ? 68 : 66;
  const float* cw = p.ffn_conv_w + (size_t)l * 3 * 5632;
  const float* cb = p.ffn_conv_b + (size_t)l * 5632;
  XCD_ITEMS_BEGIN(ntk, 22)
    const int tk = tti;
    int rs, len, ti_; bool isctx = false;
    if (l == 0) { int b = tk / 34, i = tk % 34; if (i < 1) { rs = b * RB; len = NCTX; ti_ = 0; isctx = true; } else { rs = b * RB + NCTX; len = NMAIN; ti_ = i - 1; } }
    else { int b = tk / 33; rs = b * RB + NCTX; len = NMAIN; ti_ = tk % 33; }
    const int q0 = isctx ? 0 : 254 * ti_ - 1;
    f32x16 acc[4][2]; zero_acc<4>(acc);
    gemm_core<4, true>(cx, W + (size_t)ft * 256 * 1024, 1024, H, 1024, rs + q0, rs, rs + len - 1, 1024, acc, lds);
#pragma unroll 1
    for (int fh = 0; fh < 2; ++fh) {
      if (wm == fh) {
#pragma unroll
        for (int ti = 0; ti < 2; ++ti)
#pragma unroll
          for (int fi = 0; fi < 4; ++fi)
#pragma unroll
            for (int g = 0; g < 4; ++g) {
              const int tokl = wn * 64 + ti * 32 + l31, fl = fi * 32 + 8 * g + 4 * h;
              *(float4*)(U + tokl * 132 + fl) = make_float4(acc[fi][ti][4 * g], acc[fi][ti][4 * g + 1], acc[fi][ti][4 * g + 2], acc[fi][ti][4 * g + 3]);
            }
      }
      __syncthreads();
      {
        const int j = tid & 63, c = tid >> 6;
        const int fv = ft * 128 + fh * 64 + j, fg = 2816 + fv;
        const float wv0 = cw[fv], wv1 = cw[5632 + fv], wv2 = cw[2 * 5632 + fv], bv = cb[fv];
        const float wg0 = cw[fg], wg1 = cw[5632 + fg], wg2 = cw[2 * 5632 + fg], bg = cb[fg];
        const int t0 = (isctx ? 0 : 1) + 32 * c, t1 = min(t0 + 32, isctx ? 256 : 255);
        float pv = (q0 + t0 - 1 >= 0) ? U[(t0 - 1) * 132 + j] : 0.f, pg = (q0 + t0 - 1 >= 0) ? U[(t0 - 1) * 132 + 64 + j] : 0.f;
        float cv = U[t0 * 132 + j], cgt = U[t0 * 132 + 64 + j];
        for (int t = t0; t < t1; ++t) {
          const int q = q0 + t;
          if (q >= len) break;
          float nv = (q + 1 < len) ? U[(t + 1) * 132 + j] : 0.f, ng = (q + 1 < len) ? U[(t + 1) * 132 + 64 + j] : 0.f;
          float val = wv0 * pv + wv1 * cv + wv2 * nv + bv;
          float gat = wg0 * pg + wg1 * cgt + wg2 * ng + bg;
          float a = silu_f(gat) * val;
          __builtin_nontemporal_store((bf16_t)(pack2(a, 0.f) & 0xffff), &ACT[(size_t)(rs + q) * 2816 + fv]);
          pv = cv; pg = cgt; cv = nv; cgt = ng;
        }
      }
      __syncthreads();
    }
  XCD_ITEMS_END
}

DI void final_phase(const Ctx cx, const Params& p) {
  const int tid = cx.tid, lane = tid & 63, wave = tid >> 6;
  for (int r = cx.bid * 8 + wave; r < 2 * NMAIN; r += gridDim.x * 8) {
    float* xr = p.out + (size_t)r * DM;
    float4 xv[4]; float ss = 0.f;
#pragma unroll
    for (int i = 0; i < 4; ++i) { xv[i] = *(const float4*)(xr + i * 256 + lane * 4); ss += xv[i].x * xv[i].x + xv[i].y * xv[i].y + xv[i].z * xv[i].z + xv[i].w * xv[i].w; }
    ss = wave_sum(ss);
    const float rstd = rsqrtf(ss * (1.f / 1024.f) + EPS);
#pragma unroll
    for (int i = 0; i < 4; ++i) {
      float4 g = *(const float4*)(p.final_norm + i * 256 + lane * 4);
      float4 o = make_float4(xv[i].x * rstd * g.x, xv[i].y * rstd * g.y, xv[i].z * rstd * g.z, xv[i].w * rstd * g.w);
      *(float4*)(xr + i * 256 + lane * 4) = o;
    }
  }
}


#define XB_TMO      128
#define XB_XCNT(j)  (256  + 64 * (j))
#define XB_XSUB(j)  (1280 + 64 * (j))
#define XB_XGEN(j)  (2304 + 64 * (j))
#define XB_TOP      3328
#define XB_TOPGEN   3392
#define XCD_BAR_WORDS 3456
#define XB_SPIN_CAP (1u << 20)
#define LAS __attribute__((address_space(3)))
DI unsigned xb_ld(unsigned* p)              { return __hip_atomic_load(p, __ATOMIC_RELAXED, __HIP_MEMORY_SCOPE_AGENT); }
DI unsigned xb_add(unsigned* p, unsigned v) { return __hip_atomic_fetch_add(p, v, __ATOMIC_RELAXED, __HIP_MEMORY_SCOPE_AGENT); }
DI unsigned xb_xcc_id() { return (unsigned)__builtin_amdgcn_s_getreg((3 << 11) | 20) & 0xFu; }
#define XB_SPIN(cond, bar) do { unsigned _sp = 0; while (cond) { __builtin_amdgcn_s_sleep(1); \
    if ((++_sp & 255u) == 0u) { if (xb_ld(&(bar)[XB_TMO])) break; if (_sp > XB_SPIN_CAP) { atomicAdd(&(bar)[XB_TMO], 1u); break; } } } } while (0)
struct XcdBarrier { unsigned* bar; unsigned x; volatile LAS unsigned* st; };
DI XcdBarrier xcd_barrier_post(unsigned* bar, volatile LAS unsigned* st) {
  XcdBarrier b; b.bar = bar; b.x = xb_xcc_id(); b.st = st;
  if (threadIdx.x == 0) (void)xb_add(&bar[XB_XCNT(b.x)], 1u);
  return b;
}
DI void xcd_barrier_complete(unsigned* bar, unsigned x, unsigned& nloc, unsigned& nx) {
  const unsigned G = gridDim.x * gridDim.y * gridDim.z;
  unsigned sum, cnt, mine, sp = 0u;
  for (;;) {
    sum = 0u; cnt = 0u; mine = 0u;
#pragma unroll
    for (unsigned j = 0; j < 16; ++j) { const unsigned c = xb_ld(&bar[XB_XCNT(j)]); sum += c; cnt += (c > 0u) ? 1u : 0u; mine = (j == x) ? c : mine; }
    if (sum == G) break;
    __builtin_amdgcn_s_sleep(1);
    if ((++sp & 255u) == 0u) { if (xb_ld(&bar[XB_TMO])) break; if (sp > XB_SPIN_CAP) { atomicAdd(&bar[XB_TMO], 1u); break; } }
  }
  nloc = mine > 0u ? mine : 1u; nx = cnt > 0u ? cnt : 1u;
}
DI void xcd_barrier(const XcdBarrier& b, const int tid) {
  asm volatile("s_waitcnt vmcnt(0)" ::: "memory");
  __syncthreads();
  if (tid == 0) {
    unsigned* bar = b.bar;
    __builtin_amdgcn_s_waitcnt(0);
    unsigned nloc = b.st[0], nx = b.st[1];
    if (nloc == 0u) { xcd_barrier_complete(bar, b.x, nloc, nx); b.st[0] = nloc; b.st[1] = nx; }
    const unsigned old = xb_add(&bar[XB_XSUB(b.x)], 1u);
    const unsigned gen = old / nloc;
    if (old + 1u == (gen + 1u) * nloc) {
      __builtin_amdgcn_fence(__ATOMIC_RELEASE, "agent");
      asm volatile("s_waitcnt vmcnt(0)" ::: "memory");
      const unsigned og = xb_add(&bar[XB_TOP], 1u);
      const unsigned tg = og / nx;
      if (og + 1u == (tg + 1u) * nx) xb_add(&bar[XB_TOPGEN], 1u);
      else XB_SPIN(xb_ld(&bar[XB_TOPGEN]) == tg, bar);
      __builtin_amdgcn_fence(__ATOMIC_ACQUIRE, "agent");
      xb_add(&bar[XB_XGEN(b.x)], 1u);
      asm volatile("s_waitcnt vmcnt(0)" ::: "memory");
    } else {
      XB_SPIN(xb_ld(&bar[XB_XGEN(b.x)]) == gen, bar);
      __builtin_amdgcn_fence(__ATOMIC_ACQUIRE, "agent");
      asm volatile("s_waitcnt vmcnt(0)" ::: "memory");
    }
  }
  __syncthreads();
}

constexpr int NPHASES = 20;
DI void run_phase(const Ctx cx, const Params& p, int ph, char* lds, int slot_add = 0) {
  if (ph == 0) { prep0(cx, p, lds); return; }
  if (ph == NPHASES - 1) { final_phase(cx, p); return; }
  const int l = (ph - 1) / 9, s = (ph - 1) % 9;
  switch (s) {
    case 0: if (l == 1) convert_mix(cx, p, 1, lds); norm_phase(cx, p, l, 0, l == 0, l == 0, false, lds); break;
    case 1: gemm_in_phase(cx, p, l, lds, slot_add >= 100); break;
    case 2: gemm_mla_phase(cx, p, lds); break;
    case 3: attn_phase(cx, p, l, l + slot_add, lds); break;
    case 4: merge_phase(cx, p, l, lds); break;
    case 5: resid_gemm_phase(cx, p, l, (const bf16_t*)(p.ws + OFF_WOUT), 1024, (const bf16_t*)(p.ws + OFF_M), 2, l == 0, lds, slot_add >= 100); break;
    case 6: convert_ffn(cx, p, l, lds); norm_phase(cx, p, l, 1, false, false, l == 1, lds); break;
    case 7: ffn_up_phase(cx, p, l, lds); break;
    case 8: resid_gemm_phase(cx, p, l, (const bf16_t*)(p.ws + OFF_WDN), 2816, (const bf16_t*)(p.ws + OFF_ACT), 5, false, lds); break;
  }
}

__global__ void __launch_bounds__(512, 2) mega(Params p, int ph_lo, int ph_hi) {
  extern __shared__ __attribute__((aligned(16))) char lds[];
  __shared__ uint4 xb_words;
  if (threadIdx.x == 0) xb_words = make_uint4(0u, 0u, 0u, 0u);
  __syncthreads();
  const XcdBarrier xb = xcd_barrier_post((unsigned*)(p.ws + OFF_BAR), (volatile LAS unsigned*)&xb_words);
#define GRID_SYNC(PH) do { if ((PH) == 0) cg::this_grid().sync(); else xcd_barrier(xb, cx.tid); } while (0)
#define STEP(PH) if (ph_lo <= (PH) && (PH) < ph_hi) { \
    Ctx cx; cx.tid = __builtin_amdgcn_workitem_id_x(); cx.bid = __builtin_amdgcn_workgroup_id_x(); \
    asm volatile("" : "+v"(cx.tid)); asm volatile("" : "+v"(cx.bid)); cx.bid = __builtin_amdgcn_readfirstlane(cx.bid); \
    Params q = p; int zoff = 0; asm volatile("" : "+v"(zoff)); zoff = __builtin_amdgcn_readfirstlane(zoff); q.ws = p.ws + (size_t)(unsigned)zoff; \
    run_phase(cx, q, (PH), lds); \
    if ((PH) + 1 < ph_hi) GRID_SYNC(PH); }
#define RSTEP(PH, SA) { Ctx cx; cx.tid = __builtin_amdgcn_workitem_id_x(); cx.bid = __builtin_amdgcn_workgroup_id_x(); \
    asm volatile("" : "+v"(cx.tid)); asm volatile("" : "+v"(cx.bid)); cx.bid = __builtin_amdgcn_readfirstlane(cx.bid); \
    Params q = p; int zoff = 0; asm volatile("" : "+v"(zoff)); zoff = __builtin_amdgcn_readfirstlane(zoff); q.ws = p.ws + (size_t)(unsigned)zoff; \
    int sa_ = (SA); asm volatile("" : "+v"(sa_)); sa_ = __builtin_amdgcn_readfirstlane(sa_); run_phase(cx, q, (PH), lds, sa_); xcd_barrier(xb, cx.tid); }
#if PROBE == 0
  STEP(0) STEP(1) STEP(2) STEP(3) STEP(4) STEP(5) STEP(6) STEP(7) STEP(8) STEP(9)
#elif PROBE == 1
  STEP(0) STEP(1) STEP(2) RSTEP(2, 0) STEP(3) STEP(4) STEP(5) STEP(6) STEP(7) STEP(8) STEP(9)
#elif PROBE == 2
  STEP(0) STEP(1) STEP(2) STEP(3) STEP(4) RSTEP(2, 0) RSTEP(3, 0) RSTEP(4, 2) STEP(5) STEP(6) STEP(7) STEP(8) STEP(9)
#elif PROBE == 3
  STEP(0) STEP(1) STEP(2) STEP(3) STEP(4) STEP(5) RSTEP(5, 0) STEP(6) STEP(7) STEP(8) STEP(9)
#elif PROBE == 7
  STEP(0) RSTEP(0, 0) STEP(1) STEP(2) STEP(3) STEP(4) STEP(5) STEP(6) STEP(7) STEP(8) STEP(9)
#elif PROBE == 8
  STEP(0) STEP(1) STEP(2) STEP(3) STEP(4) STEP(5) STEP(6) STEP(7) RSTEP(7, 0) STEP(8) STEP(9)
#elif PROBE == 9
  STEP(0) STEP(1) RSTEP(1, 0) STEP(2) STEP(3) RSTEP(3, 0) STEP(4) STEP(5) STEP(6) STEP(7) STEP(8) STEP(9)
#elif PROBE == 10
  STEP(0) STEP(1) STEP(2) RSTEP(2, 100) STEP(3) STEP(4) STEP(5) STEP(6) RSTEP(6, 100) STEP(7) STEP(8) STEP(9)
#elif PROBE == 5
  STEP(0) STEP(1) STEP(2) STEP(3) STEP(4) STEP(5) STEP(6) RSTEP(6, 0) STEP(7) STEP(8) STEP(9)
#elif PROBE == 6
  STEP(0) STEP(1) STEP(2) STEP(3) STEP(4) STEP(5) STEP(6) STEP(7) STEP(8) RSTEP(8, 0) STEP(9)
#elif PROBE == 4
  STEP(0) RSTEP(0, 0) STEP(1) RSTEP(1, 0) STEP(2) STEP(3) RSTEP(3, 0) STEP(4) STEP(5) STEP(6) STEP(7) RSTEP(7, 0) STEP(8) STEP(9)
#endif
  STEP(10) STEP(11) STEP(12) STEP(13) STEP(14) STEP(15) STEP(16) STEP(17) STEP(18) STEP(19)
}

extern "C" void kernel_launch(void* const* d_in, const int* in_sizes, int n_in, void* d_out, int out_size, void* d_ws, size_t ws_size, hipStream_t stream) {
  static int grid_blocks = 0;
  if (!grid_blocks) {
    hipFuncSetAttribute((const void*)mega, hipFuncAttributeMaxDynamicSharedMemorySize, LDS_BYTES);
    int dev = 0, cus = 0, per_cu = 0;
    hipGetDevice(&dev);
    hipDeviceGetAttribute(&cus, hipDeviceAttributeMultiprocessorCount, dev);
    hipOccupancyMaxActiveBlocksPerMultiprocessor(&per_cu, mega, NTH, LDS_BYTES);
    if (per_cu > 1) per_cu = 1;
    if (per_cu < 1) per_cu = 1;
    grid_blocks = cus * per_cu;
    if (ws_size < WS_NEED) fprintf(stderr, "workspace too small: %zu < %zu\n", ws_size, (size_t)WS_NEED);
  }
  Params p{};
  const float* const* in = (const float* const*)d_in;
  p.x = in[0]; p.c = in[1]; p.ctx = in[2]; p.c_ctx = in[3]; p.w_mod = in[4]; p.b_mod = in[5]; p.w_in = in[6]; p.diff_lambda = in[7];
  p.diff_subln = in[8]; p.mla_q_norm = in[9]; p.mla_kv_norm = in[10]; p.mla_w_uq = in[11]; p.mla_w_ukv = in[12]; p.gqa_q_norm = in[13];
  p.gqa_k_norm = in[14]; p.swa_sink = in[15]; p.w_branch = in[16]; p.w_out = in[17]; p.ffn_w_up = in[18]; p.ffn_conv_w = in[19];
  p.ffn_conv_b = in[20]; p.ffn_w_down = in[21]; p.final_norm = in[22];
  p.out = (float*)d_out; p.ws = (char*)d_ws;
#if MK_COOP
  hipMemsetAsync((char*)d_ws + OFF_BAR, 0, XCD_BAR_WORDS * sizeof(unsigned), stream);
  int lo = 0, hi = NPHASES;
  void* args[] = {&p, &lo, &hi};
  hipError_t e = hipLaunchCooperativeKernel((const void*)mega, dim3(grid_blocks), dim3(NTH), args, LDS_BYTES, stream);
  if (e != hipSuccess) fprintf(stderr, "cooperative launch failed: %s (grid %d)\n", hipGetErrorString(e), grid_blocks);
#else
  for (int ph = 0; ph < NPHASES; ++ph) hipLaunchKernelGGL(mega, dim3(grid_blocks), dim3(NTH), LDS_BYTES, stream, p, ph, ph + 1);
#endif
}
```

```cpp
#include <hip/hip_runtime.h>
#include <hip/hip_cooperative_groups.h>
#include <cstdio>
#include <cstdint>
namespace cg = cooperative_groups;

#ifndef PROBE
#define PROBE 0
#endif
#ifndef MK_COOP
#define MK_COOP 1
#endif

typedef unsigned short bf16_t;
typedef short bf16x8 __attribute__((ext_vector_type(8)));
typedef short s16x4 __attribute__((ext_vector_type(4)));
typedef float f32x16 __attribute__((ext_vector_type(16)));
typedef float f32x4 __attribute__((ext_vector_type(4)));
typedef __bf16 bf16x2_t __attribute__((ext_vector_type(2)));
#define DI __device__ __forceinline__
struct Ctx { int tid, bid; };
#define MFMA(a, b, c) __builtin_amdgcn_mfma_f32_32x32x16_bf16((a), (b), (c), 0, 0, 0)

constexpr int R = 16896, RB = 8448, NMAIN = 8192, NCTX = 256, DM = 1024;
constexpr int LDS_BYTES = 139264;
constexpr int NTH = 512;
constexpr int LDS_MISC = 131072;
constexpr float EPS = 1e-6f;
constexpr float LOG2E = 1.4426950408889634f;

constexpr size_t SZ_R512 = (size_t)R * 512 * 2, SZ_R128 = (size_t)R * 128 * 2, SZ_R768 = (size_t)R * 768 * 2, SZ_R1024 = (size_t)R * 1024 * 2;
constexpr size_t OFF_CTR = 0;
constexpr size_t OFF_MODP = 256;
constexpr size_t OFF_MODV = OFF_MODP + (size_t)2 * 8 * 3 * 6144 * 4;
constexpr size_t OFF_T64 = OFF_MODV + (size_t)2 * 3 * 6144 * 4;
constexpr size_t OFF_T32 = OFF_T64 + 128 * 16 * 8;
constexpr size_t OFF_XCTX = OFF_T32 + 128 * 8 * 8;
constexpr size_t OFF_WIN = OFF_XCTX + (size_t)512 * 1024 * 4;
constexpr size_t OFF_WUQ = OFF_WIN + (size_t)7936 * 1024 * 2;
constexpr size_t OFF_WUKV = OFF_WUQ + (size_t)768 * 256 * 2;
constexpr size_t OFF_WBR = OFF_WUKV + (size_t)1024 * 256 * 2;
constexpr size_t OFF_WOUT = OFF_WBR + (size_t)4 * 1024 * 512 * 2;
constexpr size_t OFF_H = OFF_WOUT + (size_t)1024 * 1024 * 2;
constexpr size_t OFF_BIG = OFF_H + SZ_R1024;
constexpr size_t OFF_QA = OFF_BIG;
constexpr size_t OFF_KA = OFF_QA + SZ_R512;
constexpr size_t OFF_VA = OFF_KA + SZ_R512;
constexpr size_t OFF_QC = OFF_VA + SZ_R512;
constexpr size_t OFF_KC = OFF_QC + SZ_R512;
constexpr size_t OFF_VC = OFF_KC + SZ_R128;
constexpr size_t OFF_QD = OFF_VC + SZ_R128;
constexpr size_t OFF_KD = OFF_QD + SZ_R512;
constexpr size_t OFF_VD = OFF_KD + SZ_R128;
constexpr size_t OFF_QB = OFF_VD + SZ_R128;
constexpr size_t OFF_KB = OFF_QB + SZ_R768;
constexpr size_t OFF_VB = OFF_KB + SZ_R768;
constexpr size_t OFF_OB = OFF_VB + SZ_R512;
constexpr size_t OFF_END_MIX = OFF_OB + SZ_R512;
constexpr size_t OFF_M = OFF_KA;
constexpr size_t OFF_WUP = OFF_BIG;
constexpr size_t OFF_WDN = OFF_WUP + (size_t)5632 * 1024 * 2;
constexpr size_t OFF_ACT = OFF_WDN + (size_t)1024 * 2816 * 2;
constexpr size_t OFF_END_FFN = OFF_ACT + (size_t)R * 2816 * 2;
constexpr size_t OFF_BAR = ((OFF_END_MIX > OFF_END_FFN ? OFF_END_MIX : OFF_END_FFN) + 4095) / 4096 * 4096;
constexpr size_t WS_NEED = OFF_BAR + 16384;

struct Params {
  const float *x, *c, *ctx, *c_ctx, *w_mod, *b_mod, *w_in, *diff_lambda, *diff_subln, *mla_q_norm, *mla_kv_norm, *mla_w_uq, *mla_w_ukv,
      *gqa_q_norm, *gqa_k_norm, *swa_sink, *w_branch, *w_out, *ffn_w_up, *ffn_conv_w, *ffn_conv_b, *ffn_w_down, *final_norm;
  float* out;
  char* ws;
};

DI unsigned pack2(float a, float b) { bf16x2_t v; v.x = (__bf16)a; v.y = (__bf16)b; return __builtin_bit_cast(unsigned, v); }
DI float bf2f(bf16_t v) { return __uint_as_float(((unsigned)v) << 16); }
DI float swap_max(float x) { auto r = __builtin_amdgcn_permlane32_swap(__float_as_uint(x), __float_as_uint(x), false, false); return fmaxf(__uint_as_float(r[0]), __uint_as_float(r[1])); }
DI float swap_sum(float x) { auto r = __builtin_amdgcn_permlane32_swap(__float_as_uint(x), __float_as_uint(x), false, false); return __uint_as_float(r[0]) + __uint_as_float(r[1]); }
DI float wave_sum(float v) { for (int o = 32; o > 0; o >>= 1) v += __shfl_xor(v, o); return v; }
DI float silu_f(float v) { return v / (1.f + __expf(-v)); }
DI float sigmoid_f(float v) { return 1.f / (1.f + __expf(-v)); }
DI const float* x_row_src(const Params& p, bool from_inputs, int r) {
  int b = r >= RB ? 1 : 0, pp = r - b * RB;
  if (pp < NCTX) return (from_inputs ? p.ctx : (const float*)(p.ws + OFF_XCTX)) + (size_t)(b * NCTX + pp) * DM;
  return (from_inputs ? p.x : (const float*)p.out) + (size_t)(b * NMAIN + pp - NCTX) * DM;
}
DI float* x_row_dst(const Params& p, int r) {
  int b = r >= RB ? 1 : 0, pp = r - b * RB;
  if (pp < NCTX) return (float*)(p.ws + OFF_XCTX) + (size_t)(b * NCTX + pp) * DM;
  return p.out + (size_t)(b * NMAIN + pp - NCTX) * DM;
}
DI int variant_of(int r) { int b = r >= RB ? 1 : 0, pp = r - b * RB; return pp < NCTX ? 2 : b; }
DI int tt_of(int layer, int idx) { return layer == 0 ? idx : (idx >> 5) * 33 + 1 + (idx & 31); }

#define XCD_ITEMS_BEGIN(NT_, NF_) { const int nbx_ = (int)gridDim.x >> 3, xx_ = cx.bid & 7, nown_ = (NT_) >> 3, town_ = nown_ * (NF_); \
  const int nlo_ = ((NT_) - 8 * nown_) * (NF_), text_ = (nlo_ > xx_) ? (nlo_ - xx_ + 7) >> 3 : 0;     \
  for (int q_ = cx.bid >> 3; q_ < town_ + text_; q_ += nbx_) { int ft, tti; \
    if (q_ < town_) { const int g_ = q_ / (8 * (NF_)), r_ = q_ - g_ * 8 * (NF_), gs_ = min(8, nown_ - 8 * g_); \
      ft = r_ / gs_; tti = xx_ + 8 * (8 * g_ + (r_ - ft * gs_)); } \
    else { const int e_ = xx_ + 8 * (q_ - town_); tti = 8 * nown_ + e_ / (NF_); ft = e_ - (tti - 8 * nown_) * (NF_); }
#define XCD_ITEMS_END } }
template <int MF, bool CLAMP = false>
DI void gemm_core(const Ctx cx, const bf16_t* __restrict__ W, int ldw, const bf16_t* __restrict__ X, int ldx, int rbase, int rlo, int rhi, int K,
                  f32x16 (&acc)[MF][2], char* lds) {
  constexpr int AB = 64 * MF * 128, SS = AB + 32768;
  const int tid = cx.tid, lane = tid & 63, wave = tid >> 6, wm = wave >> 2, wn = wave & 3, l31 = lane & 31, h = lane >> 5;
  const int srow = tid >> 3, sch = (tid & 7) ^ ((srow >> 1) & 7);
  const bf16_t* wp = W + (size_t)srow * ldw + sch * 8;
  const bf16_t* xp[4];
  if (CLAMP) {
#pragma unroll
    for (int c = 0; c < 4; ++c) { int xr = min(max(rbase + srow + 64 * c, rlo), rhi); xp[c] = X + (size_t)xr * ldx + sch * 8; }
  } else {
    xp[0] = X + (size_t)(rbase + srow) * ldx + sch * 8;
  }
  char* lw = lds + tid * 16;
  const int swz = (l31 >> 1) & 7;
  const int offA = (wm * 32 * MF + l31) * 128, offB = AB + (wn * 64 + l31) * 128;
  const int nk = K >> 6;
#define GSTAGE(buf_, ko_) do { char* d_ = lw + (buf_) * SS; \
    _Pragma("unroll") for (int c = 0; c < MF; ++c) \
      __builtin_amdgcn_global_load_lds((const unsigned*)(wp + (size_t)(64 * c) * ldw + (ko_)), (__attribute__((address_space(3))) unsigned*)(d_ + 8192 * c), 16, 0, 0); \
    _Pragma("unroll") for (int c = 0; c < 4; ++c) \
      __builtin_amdgcn_global_load_lds((const unsigned*)((CLAMP ? xp[c] : xp[0] + (size_t)(64 * c) * ldx) + (ko_)), (__attribute__((address_space(3))) unsigned*)(d_ + AB + 8192 * c), 16, 0, 0); } while (0)
  GSTAGE(0, 0);
  __syncthreads();
  int buf = 0;
  for (int kt = 0; kt < nk; ++kt) {
    if (kt + 1 < nk) GSTAGE(buf ^ 1, (kt + 1) * 64);
    const char* base = lds + buf * SS;
    bf16x8 a[2][MF], b[2][2];
    {
      const int co = (h ^ swz) << 4;
#pragma unroll
      for (int fi = 0; fi < MF; ++fi) a[0][fi] = *(const bf16x8*)(base + offA + fi * 4096 + co);
      b[0][0] = *(const bf16x8*)(base + offB + co); b[0][1] = *(const bf16x8*)(base + offB + 4096 + co);
    }
#pragma unroll
    for (int s = 0; s < 4; ++s) {
      if (s < 3) {
        const int co = ((2 * (s + 1) + h) ^ swz) << 4;
#pragma unroll
        for (int fi = 0; fi < MF; ++fi) a[(s + 1) & 1][fi] = *(const bf16x8*)(base + offA + fi * 4096 + co);
        b[(s + 1) & 1][0] = *(const bf16x8*)(base + offB + co); b[(s + 1) & 1][1] = *(const bf16x8*)(base + offB + 4096 + co);
      }
#pragma unroll
      for (int fi = 0; fi < MF; ++fi) { acc[fi][0] = MFMA(a[s & 1][fi], b[s & 1][0], acc[fi][0]); acc[fi][1] = MFMA(a[s & 1][fi], b[s & 1][1], acc[fi][1]); }
    }
    __syncthreads();
    buf ^= 1;
  }
#undef GSTAGE
}
template <int MF>
DI void zero_acc(f32x16 (&acc)[MF][2]) {
#pragma unroll
  for (int a = 0; a < MF; ++a)
#pragma unroll
    for (int b = 0; b < 2; ++b)
#pragma unroll
      for (int i = 0; i < 16; ++i) acc[a][b][i] = 0.f;
}

DI int rowmap_win(int n) {
  if (n < 1536) return n;
  if (n < 1792) return 3072 + (n - 1536);
  if (n < 2048) return 3328 + (n - 1792);
  if (n < 2080) return 3584 + (n - 2048);
  if (n < 2592) return 1536 + (n - 2080);
  if (n < 2720) return 2048 + (n - 2592);
  if (n < 2848) return 2176 + (n - 2720);
  if (n < 3360) return 2304 + (n - 2848);
  if (n < 3488) return 2816 + (n - 3360);
  if (n < 3616) return 2944 + (n - 3488);
  return 3840 + (n - 3616);
}
DI int rowmap(int mode, int n) {
  switch (mode) {
    case 1: return rowmap_win(n);
    case 2: { int hd = n / 96, d = n - hd * 96; return d < 64 ? hd * 64 + d : 512 + hd * 32 + (d - 64); }
    case 3: { int hd = n >> 7, d = n & 127; return d < 64 ? hd * 64 + d : 512 + hd * 64 + (d - 64); }
    case 4: { if (n < 2816) return 128 * (n >> 6) + (n & 63); int f = n - 2816; return 128 * (f >> 6) + 64 + (f & 63); }
    default: return n;
  }
}
DI void convert_tile(const Ctx cx, const float* __restrict__ src, int N, bf16_t* __restrict__ dst, int ldd, int mode, const float* __restrict__ kscale, int kt, int nt, char* lds) {
  float* lf = (float*)lds;
  const int tid = cx.tid, k0 = kt * 64, n0 = nt * 64;
#pragma unroll
  for (int i = 0; i < 8; ++i) { int e = tid + 512 * i, kk = e >> 6, nn = e & 63; lf[kk * 65 + nn] = (n0 + nn < N) ? src[(size_t)(k0 + kk) * N + n0 + nn] : 0.f; }
  __syncthreads();
  const int nn = tid >> 3, kc = tid & 7;
  float v[8];
#pragma unroll
  for (int j = 0; j < 8; ++j) { v[j] = lf[(kc * 8 + j) * 65 + nn]; if (kscale) v[j] *= kscale[k0 + kc * 8 + j]; }
  uint4 o; o.x = pack2(v[0], v[1]); o.y = pack2(v[2], v[3]); o.z = pack2(v[4], v[5]); o.w = pack2(v[6], v[7]);
  if (n0 + nn < N) *(uint4*)(dst + (size_t)rowmap(mode, n0 + nn) * ldd + k0 + kc * 8) = o;
  __syncthreads();
}
DI void convert_mix(const Ctx cx, const Params& p, int l, char* lds) {
  const int NI = 1936 + 48 + 64 + 512 + 256 + 224;
  for (int it = cx.bid; it < NI; it += gridDim.x) {
    if (it < 1936) { convert_tile(cx, p.w_in + (size_t)l * 1024 * 7712, 7712, (bf16_t*)(p.ws + OFF_WIN), 1024, 1, nullptr, it / 121, it % 121, lds); continue; }
    int i = it - 1936;
    if (i < 48) { convert_tile(cx, p.mla_w_uq + (size_t)l * 256 * 768, 768, (bf16_t*)(p.ws + OFF_WUQ), 256, 2, p.mla_q_norm + l * 256, i / 12, i % 12, lds); continue; }
    i -= 48;
    if (i < 64) { convert_tile(cx, p.mla_w_ukv + (size_t)l * 256 * 1024, 1024, (bf16_t*)(p.ws + OFF_WUKV), 256, 3, p.mla_kv_norm + l * 256, i / 16, i % 16, lds); continue; }
    i -= 64;
    if (i < 512) { int k = i >> 7, j = i & 127; convert_tile(cx, p.w_branch + ((size_t)l * 4 + k) * 512 * 1024, 1024, (bf16_t*)(p.ws + OFF_WBR) + (size_t)k * 1024 * 512, 512, 0, nullptr, j / 16, j % 16, lds); continue; }
    i -= 512;
    if (i < 256) { convert_tile(cx, p.w_out + (size_t)l * 1024 * 1024, 1024, (bf16_t*)(p.ws + OFF_WOUT), 1024, 0, nullptr, i / 16, i % 16, lds); continue; }
    i -= 256;
    *(unsigned*)((bf16_t*)(p.ws + OFF_WIN) + (size_t)(3616 + i) * 1024 + cx.tid * 2) = 0u;
  }
}
DI void convert_ffn(const Ctx cx, const Params& p, int l, char* lds) {
  const int NI = 1408 + 704;
  for (int it = cx.bid; it < NI; it += gridDim.x) {
    if (it < 1408) { convert_tile(cx, p.ffn_w_up + (size_t)l * 1024 * 5632, 5632, (bf16_t*)(p.ws + OFF_WUP), 1024, 4, nullptr, it / 88, it % 88, lds); continue; }
    int i = it - 1408;
    convert_tile(cx, p.ffn_w_down + (size_t)l * 2816 * 1024, 1024, (bf16_t*)(p.ws + OFF_WDN), 2816, 0, nullptr, i / 16, i % 16, lds);
  }
}

DI void sincos_d(double ang, float& co, float& si) {
  const double TWO_PI = 6.283185307179586476925286766559;
  double k = rint(ang / TWO_PI);
  double r = ang - k * TWO_PI;
  double r2 = r * r, ts = r, tc = 1.0, s = r, c = 1.0;
  for (int i = 1; i <= 16; ++i) {
    tc *= -r2 / (double)((2 * i - 1) * (2 * i));
    ts *= -r2 / (double)((2 * i) * (2 * i + 1));
    c += tc; s += ts;
  }
  co = (float)c; si = (float)s;
}
DI void prep0(const Ctx cx, const Params& p, char* lds) {
  const int tid = cx.tid;
  if (cx.bid == 0 && tid < 64) ((int*)(p.ws + OFF_CTR))[tid] = 0;
  for (int idx = cx.bid * NTH + tid; idx < 128 * 16 + 128 * 8; idx += gridDim.x * NTH) {
    if (idx < 2048) {
      int pos = idx >> 4, i = idx & 15;
      double inv = 1.0; for (int j = 0; j < i; ++j) inv *= 0.5623413251903491;
      float co, si; sincos_d((double)pos * inv, co, si);
      ((float2*)(p.ws + OFF_T64))[idx] = make_float2(co, si);
    } else {
      int e = idx - 2048, pos = e >> 3, i = e & 7;
      double inv = 1.0; for (int j = 0; j < i; ++j) inv *= 0.31622776601683794;
      float co, si; sincos_d((double)pos * inv, co, si);
      ((float2*)(p.ws + OFF_T32))[e] = make_float2(co, si);
    }
  }
  float* sl = (float*)lds;
  for (int it = cx.bid; it < 192; it += gridDim.x) {
    int l = it / 96, r = it % 96, cc = r >> 3, kc = r & 7;
    __syncthreads();
    if (tid < 128) {
      int k = kc * 128 + tid;
      sl[tid] = silu_f(p.c[k]); sl[128 + tid] = silu_f(p.c[1024 + k]); sl[256 + tid] = silu_f(p.c_ctx[k]);
    }
    __syncthreads();
    const int col = cc * NTH + tid;
    const float* w = p.w_mod + ((size_t)l * 1024 + kc * 128) * 6144 + col;
    float a0 = 0.f, a1 = 0.f, a2 = 0.f;
#pragma unroll 8
    for (int k = 0; k < 128; ++k) { float wv = w[(size_t)k * 6144]; a0 += sl[k] * wv; a1 += sl[128 + k] * wv; a2 += sl[256 + k] * wv; }
    float* mp = (float*)(p.ws + OFF_MODP) + (size_t)((l * 8 + kc) * 3) * 6144 + col;
    mp[0] = a0; mp[6144] = a1; mp[2 * 6144] = a2;
  }
  __syncthreads();
  convert_mix(cx, p, 0, lds);
}

DI float mod_from_partials(const Params& p, int l, int v, int idx) {
  const float* mp = (const float*)(p.ws + OFF_MODP) + (size_t)(l * 8 * 3 + v) * 6144 + idx;
  float s = p.b_mod[l * 6144 + idx];
#pragma unroll
  for (int k = 0; k < 8; ++k) s += mp[(size_t)k * 3 * 6144];
  return s;
}
DI void norm_phase(const Ctx cx, const Params& p, int l, int which, bool from_inputs, bool partials, bool skip_ctx, char* lds) {
  const int tid = cx.tid, lane = tid & 63, wave = tid >> 6;
  float* ms = (float*)lds;
  const int sh = which ? 3 : 0;
  for (int e = tid; e < 6144; e += NTH) {
    int v = e >> 11, r = e & 2047, idx = (sh + (r >> 10)) * 1024 + (r & 1023);
    ms[e] = partials ? mod_from_partials(p, l, v, idx) : ((const float*)(p.ws + OFF_MODV))[(size_t)(l * 3 + v) * 6144 + idx];
  }
  if (partials) {
    for (int e = cx.bid * NTH + tid; e < 2 * 3 * 6144; e += gridDim.x * NTH) {
      int ll = e / (3 * 6144), r = e % (3 * 6144), v = r / 6144, idx = r % 6144;
      ((float*)(p.ws + OFF_MODV))[e] = mod_from_partials(p, ll, v, idx);
    }
  }
  __syncthreads();
  bf16_t* H = (bf16_t*)(p.ws + OFF_H);
  for (int r = cx.bid * 8 + wave; r < R; r += gridDim.x * 8) {
    const int v = variant_of(r);
    if (skip_ctx && v == 2) continue;
    const float* xr = x_row_src(p, from_inputs, r);
    float4 xv[4]; float ss = 0.f;
#pragma unroll
    for (int i = 0; i < 4; ++i) { xv[i] = *(const float4*)(xr + i * 256 + lane * 4); ss += xv[i].x * xv[i].x + xv[i].y * xv[i].y + xv[i].z * xv[i].z + xv[i].w * xv[i].w; }
    ss = wave_sum(ss);
    const float rstd = rsqrtf(ss * (1.f / 1024.f) + EPS);
    const float* shp = ms + v * 2048; const float* scp = shp + 1024;
#pragma unroll
    for (int i = 0; i < 4; ++i) {
      int c = i * 256 + lane * 4;
      float y0 = xv[i].x * rstd * (1.f + scp[c]) + shp[c], y1 = xv[i].y * rstd * (1.f + scp[c + 1]) + shp[c + 1];
      float y2 = xv[i].z * rstd * (1.f + scp[c + 2]) + shp[c + 2], y3 = xv[i].w * rstd * (1.f + scp[c + 3]) + shp[c + 3];
      uint2 o; o.x = pack2(y0, y1); o.y = pack2(y2, y3);
      *(uint2*)(H + (size_t)r * 1024 + c) = o;
    }
  }
  __syncthreads();
}

struct TokInfo { int r, b, pp, trow, tcol; bool is_main; };
DI TokInfo tok_info(int r) { TokInfo t; t.r = r; t.b = r >= RB ? 1 : 0; t.pp = r - t.b * RB; t.is_main = t.pp >= NCTX; int n = t.pp - NCTX; t.trow = (n >> 6) & 127; t.tcol = n & 63; return t; }

DI void epi_qk64(const f32x16& a0, const f32x16& a1, const TokInfo& t, int h, const float* __restrict__ gain, bool rope, float scale,
                 bf16_t* __restrict__ dst, int ld, int col, const float2* __restrict__ T64) {
  float v[2][16];
#pragma unroll
  for (int i = 0; i < 16; ++i) { v[0][i] = a0[i]; v[1][i] = a1[i]; }
  if (gain) {
    float ss = 0.f;
#pragma unroll
    for (int i = 0; i < 16; ++i) ss += v[0][i] * v[0][i] + v[1][i] * v[1][i];
    ss = swap_sum(ss);
    const float rstd = rsqrtf(ss * (1.f / 64.f) + EPS);
#pragma unroll
    for (int fi = 0; fi < 2; ++fi)
#pragma unroll
      for (int i = 0; i < 16; ++i) v[fi][i] *= rstd * gain[fi * 32 + 8 * (i >> 2) + 4 * h + (i & 3)];
  }
  if (rope && t.is_main) {
#pragma unroll
    for (int fi = 0; fi < 2; ++fi) {
      const float2* tb = T64 + (fi == 0 ? t.trow : t.tcol) * 16;
#pragma unroll
      for (int g = 0; g < 4; ++g)
#pragma unroll
        for (int jj = 0; jj < 2; ++jj) {
          float2 cs = tb[4 * g + 2 * h + jj];
          float x0 = v[fi][4 * g + 2 * jj], x1 = v[fi][4 * g + 2 * jj + 1];
          v[fi][4 * g + 2 * jj] = x0 * cs.x - x1 * cs.y;
          v[fi][4 * g + 2 * jj + 1] = x0 * cs.y + x1 * cs.x;
        }
    }
  }
  bf16_t* d = dst + (size_t)t.r * ld + col + 4 * h;
#pragma unroll
  for (int fi = 0; fi < 2; ++fi)
#pragma unroll
    for (int g = 0; g < 4; ++g) {
      uint2 o; o.x = pack2(v[fi][4 * g] * scale, v[fi][4 * g + 1] * scale); o.y = pack2(v[fi][4 * g + 2] * scale, v[fi][4 * g + 3] * scale);
      *(uint2*)(d + fi * 32 + 8 * g) = o;
    }
}
DI void epi_vt(const f32x16& a0, const f32x16& a1, const TokInfo& t, int h, bf16_t* __restrict__ VT, int nh, int head, int dv, int d0, float scale) {
  bf16_t* d = VT + ((size_t)(t.b * nh + head) * dv + d0 + 4 * h) * RB + t.pp;
#pragma unroll
  for (int i = 0; i < 16; ++i) {
    int f = 8 * (i >> 2) + (i & 3);
    d[(size_t)f * RB] = (bf16_t)(pack2(a0[i] * scale, 0.f) & 0xffff);
    d[(size_t)(32 + f) * RB] = (bf16_t)(pack2(a1[i] * scale, 0.f) & 0xffff);
  }
}
DI void epi_plain(const f32x16& a0, const f32x16& a1, const TokInfo& t, int h, bf16_t* __restrict__ dst, int ld, int col, float scale) {
  bf16_t* d = dst + (size_t)t.r * ld + col + 4 * h;
#pragma unroll
  for (int g = 0; g < 4; ++g) {
    uint2 o; o.x = pack2(a0[4 * g] * scale, a0[4 * g + 1] * scale); o.y = pack2(a0[4 * g + 2] * scale, a0[4 * g + 3] * scale);
    *(uint2*)(d + 8 * g) = o;
    uint2 q; q.x = pack2(a1[4 * g] * scale, a1[4 * g + 1] * scale); q.y = pack2(a1[4 * g + 2] * scale, a1[4 * g + 3] * scale);
    *(uint2*)(d + 32 + 8 * g) = q;
  }
}

DI void gemm_in_phase(const Ctx cx, const Params& p, int l, char* lds, int skip_epi = 0) {
  const int tid = cx.tid, lane = tid & 63, wave = tid >> 6, wm = wave >> 2, wn = wave & 3, l31 = lane & 31, h = lane >> 5;
  const bf16_t* W = (const bf16_t*)(p.ws + OFF_WIN);
  const bf16_t* H = (const bf16_t*)(p.ws + OFF_H);
  const float2* T64 = (const float2*)(p.ws + OFF_T64);
  const float2* T32 = (const float2*)(p.ws + OFF_T32);
  const float qs64 = 0.125f * LOG2E;
  XCD_ITEMS_BEGIN(66, 15)
    const int tt = tti;
    f32x16 acc[4][2]; zero_acc<4>(acc);
    gemm_core<4>(cx, W + (size_t)ft * 256 * 1024, 1024, H, 1024, tt * 256, 0, R - 1, 1024, acc, lds);
    if (skip_epi) { if (acc[0][0][0] == 12345.678f && acc[1][1][3] == 1.f && acc[2][0][5] == 2.f && acc[3][1][7] == 3.f) ((float*)(p.ws + OFF_CTR))[40] = 1.f; continue; }
#pragma unroll
    for (int gi = 0; gi < 2; ++gi) {
    const int fb = ft * 256 + wm * 128 + gi * 64;
#pragma unroll
    for (int ti = 0; ti < 2; ++ti) {
      const TokInfo t = tok_info(tt * 256 + wn * 64 + ti * 32 + l31);
      const f32x16& a0 = acc[2 * gi][ti]; const f32x16& a1 = acc[2 * gi + 1][ti];
      if (fb < 512) epi_qk64(a0, a1, t, h, nullptr, true, qs64, (bf16_t*)(p.ws + OFF_QA), 512, fb, T64);
      else if (fb < 1024) epi_qk64(a0, a1, t, h, nullptr, true, 1.f, (bf16_t*)(p.ws + OFF_KA), 512, fb - 512, T64);
      else if (fb < 1536) epi_vt(a0, a1, t, h, (bf16_t*)(p.ws + OFF_VA), 4, (fb - 1024) >> 7, 128, (fb - 1024) & 127, 1.f);
      else if (fb < 2048) epi_qk64(a0, a1, t, h, p.gqa_q_norm + l * 64, true, qs64, (bf16_t*)(p.ws + OFF_QC), 512, fb - 1536, T64);
      else if (fb < 2176) epi_qk64(a0, a1, t, h, p.gqa_k_norm + l * 64, true, 1.f, (bf16_t*)(p.ws + OFF_KC), 128, fb - 2048, T64);
      else if (fb < 2304) epi_vt(a0, a1, t, h, (bf16_t*)(p.ws + OFF_VC), 2, (fb - 2176) >> 6, 64, 0, 1.f);
      else if (fb < 2816) epi_qk64(a0, a1, t, h, nullptr, true, qs64, (bf16_t*)(p.ws + OFF_QD), 512, fb - 2304, T64);
      else if (fb < 2944) epi_qk64(a0, a1, t, h, nullptr, true, 1.f, (bf16_t*)(p.ws + OFF_KD), 128, fb - 2816, T64);
      else if (fb < 3072) epi_vt(a0, a1, t, h, (bf16_t*)(p.ws + OFF_VD), 2, (fb - 2944) >> 6, 64, 0, 1.f);
      else if (fb < 3328) epi_plain(a0, a1, t, h, (bf16_t*)(p.ws + OFF_OB), 256, fb - 3072, 1.f);
      else if (fb < 3584) epi_plain(a0, a1, t, h, (bf16_t*)(p.ws + OFF_OB) + (size_t)R * 256, 256, fb - 3328, 1.f);
      else if (fb < 3648) {
        float v[16];
#pragma unroll
        for (int i = 0; i < 16; ++i) v[i] = a0[i];
        if (t.is_main) {
#pragma unroll
          for (int g = 0; g < 4; ++g)
#pragma unroll
            for (int jj = 0; jj < 2; ++jj) {
              float2 cs = g < 2 ? T32[t.trow * 8 + 4 * g + 2 * h + jj] : T32[t.tcol * 8 + 4 * (g - 2) + 2 * h + jj];
              float x0 = v[4 * g + 2 * jj], x1 = v[4 * g + 2 * jj + 1];
              v[4 * g + 2 * jj] = x0 * cs.x - x1 * cs.y; v[4 * g + 2 * jj + 1] = x0 * cs.y + x1 * cs.x;
            }
        }
        bf16_t* d = (bf16_t*)(p.ws + OFF_KB) + (size_t)t.r * 768 + 64 + 4 * h;
#pragma unroll
        for (int g = 0; g < 4; ++g) {
          uint2 o; o.x = pack2(v[4 * g], v[4 * g + 1]); o.y = pack2(v[4 * g + 2], v[4 * g + 3]);
#pragma unroll
          for (int hd = 0; hd < 8; ++hd) *(uint2*)(d + hd * 96 + 8 * g) = o;
        }
      }
    }
    }
  XCD_ITEMS_END
}

DI void gemm_mla_phase(const Ctx cx, const Params& p, char* lds) {
  const int tid = cx.tid, lane = tid & 63, wave = tid >> 6, wm = wave >> 2, wn = wave & 3, l31 = lane & 31, h = lane >> 5;
  const float2* T32 = (const float2*)(p.ws + OFF_T32);
  float* rs = (float*)(lds + LDS_MISC);
  const float qs96 = 0.10206207261596577f * LOG2E;
  XCD_ITEMS_BEGIN(66, 7)
    const int tt = tti, fti = ft;
    const bool isq = fti < 3;
    const int ft2 = isq ? fti : fti - 3;
    const bf16_t* X = (const bf16_t*)(p.ws + OFF_OB) + (isq ? 0 : (size_t)R * 256);
    const bf16_t* W = (const bf16_t*)(p.ws + (isq ? OFF_WUQ : OFF_WUKV)) + (size_t)ft2 * 256 * 256;
    {
      const int row = tid >> 1, half = tid & 1;
      const bf16_t* xr = X + (size_t)(tt * 256 + row) * 256 + half * 128;
      float ss = 0.f;
#pragma unroll
      for (int i = 0; i < 16; ++i) {
        uint4 u = *(const uint4*)(xr + i * 8);
        unsigned w4[4] = {u.x, u.y, u.z, u.w};
#pragma unroll
        for (int j = 0; j < 4; ++j) { float a = __uint_as_float(w4[j] << 16), b = __uint_as_float(w4[j] & 0xffff0000u); ss += a * a + b * b; }
      }
      ss += __shfl_xor(ss, 1);
      if (half == 0) rs[row] = rsqrtf(ss * (1.f / 256.f) + EPS);
    }
    f32x16 acc[4][2]; zero_acc<4>(acc);
    gemm_core<4>(cx, W, 256, X, 256, tt * 256, 0, R - 1, 256, acc, lds);
#pragma unroll
    for (int gi = 0; gi < 2; ++gi) {
    const int fb = ft2 * 256 + wm * 128 + gi * 64;
#pragma unroll
    for (int ti = 0; ti < 2; ++ti) {
      const int tl = wn * 64 + ti * 32 + l31;
      const TokInfo t = tok_info(tt * 256 + tl);
      const float rstd = rs[tl];
      const f32x16& a0 = acc[2 * gi][ti]; const f32x16& a1 = acc[2 * gi + 1][ti];
      if (isq) {
        if (fb < 512) epi_plain(a0, a1, t, h, (bf16_t*)(p.ws + OFF_QB), 768, (fb >> 6) * 96, rstd * qs96);
        else {
#pragma unroll
          for (int fi = 0; fi < 2; ++fi) {
            const int head = ((fb - 512) >> 5) + fi;
            float v[16];
#pragma unroll
            for (int i = 0; i < 16; ++i) v[i] = (fi == 0 ? a0[i] : a1[i]) * (rstd * qs96);
            if (t.is_main) {
#pragma unroll
              for (int g = 0; g < 4; ++g)
#pragma unroll
                for (int jj = 0; jj < 2; ++jj) {
                  float2 cs = g < 2 ? T32[t.trow * 8 + 4 * g + 2 * h + jj] : T32[t.tcol * 8 + 4 * (g - 2) + 2 * h + jj];
                  float x0 = v[4 * g + 2 * jj], x1 = v[4 * g + 2 * jj + 1];
                  v[4 * g + 2 * jj] = x0 * cs.x - x1 * cs.y; v[4 * g + 2 * jj + 1] = x0 * cs.y + x1 * cs.x;
                }
            }
            bf16_t* d = (bf16_t*)(p.ws + OFF_QB) + (size_t)t.r * 768 + head * 96 + 64 + 4 * h;
#pragma unroll
            for (int g = 0; g < 4; ++g) { uint2 o; o.x = pack2(v[4 * g], v[4 * g + 1]); o.y = pack2(v[4 * g + 2], v[4 * g + 3]); *(uint2*)(d + 8 * g) = o; }
          }
        }
      } else {
        if (fb < 512) epi_plain(a0, a1, t, h, (bf16_t*)(p.ws + OFF_KB), 768, (fb >> 6) * 96, rstd);
        else epi_vt(a0, a1, t, h, (bf16_t*)(p.ws + OFF_VB), 8, (fb - 512) >> 6, 64, 0, rstd);
      }
    }
    }
    __syncthreads();
  XCD_ITEMS_END
}

template <int DQK, int DV, bool WINDOW>
DI void attn_core(const Ctx cx, const bf16x8 (&qf)[DQK / 16], const bf16_t* __restrict__ Kb, int ldk, const bf16_t* __restrict__ VT,
                  int n_a, int t_b0, int n_b, int qpos, float& m, float& l, f32x16 (&O)[DV / 32], char* lds) {
  constexpr int KST = DQK * 2 + 16, VST = 136, CPR = DQK / 8, NS = DQK / 16, NO = DV / 32;
  constexpr int KBUF = 64 * KST, VBASE = 2 * KBUF, VBUF = DV * VST;
  const int tid = cx.tid, lane = tid & 63, l31 = lane & 31, h = lane >> 5;
  const int krow0 = tid / CPR, kch0 = tid - krow0 * CPR;
  const int krow1 = (tid + 512) / CPR, kch1 = (tid + 512) - krow1 * CPR;
  const bool k2 = (CPR == 12) && (tid < 256);
  const int vrow0 = tid >> 3, vch = tid & 7;
  uint4 rk0, rk1 = make_uint4(0, 0, 0, 0), rv0, rv1 = make_uint4(0, 0, 0, 0);
  const int nt = n_a + n_b;
  const int tb_adj = t_b0 - n_a;
  auto tile_of = [=](int it) { return it < n_a ? it : tb_adj + it; };
#define GLOAD(tile_) do { const int tl_ = (tile_); \
    rk0 = *(const uint4*)(Kb + (size_t)(tl_ * 64 + krow0) * ldk + kch0 * 8); \
    if (k2) rk1 = *(const uint4*)(Kb + (size_t)(tl_ * 64 + krow1) * ldk + kch1 * 8); \
    rv0 = *(const uint4*)(VT + (size_t)(vrow0) * RB + tl_ * 64 + vch * 8); \
    if (DV > 64) rv1 = *(const uint4*)(VT + (size_t)(vrow0 + 64) * RB + tl_ * 64 + vch * 8); } while (0)
#define VSTORE_(rv_, c_) do { char* d_ = lds + VBASE + bb_ * VBUF + (vrow0 + 64 * (c_)) * VST + vch * 16; \
      *(uint2*)d_ = make_uint2(rv_.x, rv_.y); *(uint2*)(d_ + 8) = make_uint2(rv_.z, rv_.w); } while (0)
#define LSTORE(b_) do { const int bb_ = (b_); \
    *(uint4*)(lds + bb_ * KBUF + krow0 * KST + kch0 * 16) = rk0; \
    if (k2) *(uint4*)(lds + bb_ * KBUF + krow1 * KST + kch1 * 16) = rk1; \
    VSTORE_(rv0, 0); if (DV > 64) VSTORE_(rv1, 1); } while (0)
  constexpr bool USE_LACC = (DV == 64);
  f32x16 negm, Lacc;
  bf16x8 ones;
  float lsum = 0.f;
  if constexpr (USE_LACC) {
#pragma unroll
    for (int i = 0; i < 16; ++i) negm[i] = -m;
#pragma unroll
    for (int i = 0; i < 16; ++i) Lacc[i] = l;
#pragma unroll
    for (int i = 0; i < 8; ++i) ones[i] = (short)0x3F80;
  }
  GLOAD(tile_of(0)); LSTORE(0);
  __syncthreads();
  for (int it = 0; it < nt; ++it) {
    const int cur = it & 1;
    const bool more = it + 1 < nt;
    if (more) GLOAD(tile_of(it + 1));
    f32x16 s0, s1;
    const char* kb = lds + cur * KBUF + l31 * KST + h * 16;
    {
      bf16x8 k0 = *(const bf16x8*)(kb), k1 = *(const bf16x8*)(kb + 32 * KST);
      if constexpr (USE_LACC) { s0 = MFMA(k0, qf[0], negm); s1 = MFMA(k1, qf[0], negm); }
      else { f32x16 z_; _Pragma("unroll") for (int i = 0; i < 16; ++i) z_[i] = 0.f; s0 = MFMA(k0, qf[0], z_); s1 = MFMA(k1, qf[0], z_); }
    }
#pragma unroll
    for (int s = 1; s < NS; ++s) {
      bf16x8 k0 = *(const bf16x8*)(kb + s * 32), k1 = *(const bf16x8*)(kb + 32 * KST + s * 32);
      s0 = MFMA(k0, qf[s], s0); s1 = MFMA(k1, qf[s], s1);
    }
    if (WINDOW) {
      const int tile = tile_of(it);
      if (tile >= 4) {
        const int kp0 = tile * 64 - NCTX + 4 * h - qpos;
#pragma unroll
        for (int i = 0; i < 16; ++i) {
          int d0 = kp0 + 8 * (i >> 2) + (i & 3), d1 = d0 + 32;
          if (d0 > 128 || d0 < -128) s0[i] = -1e30f;
          if (d1 > 128 || d1 < -128) s1[i] = -1e30f;
        }
      }
    }
    if constexpr (!USE_LACC) {
#pragma unroll
      for (int i = 0; i < 16; ++i) { s0[i] -= m; s1[i] -= m; }
    }
    int im = max(__float_as_int(s0[0]), __float_as_int(s1[0]));
#pragma unroll
    for (int i = 1; i < 16; ++i) im = max(im, max(__float_as_int(s0[i]), __float_as_int(s1[i])));
    const bool force = (!WINDOW) && (it == 0);
    if (force || __any(im > 0x41000000)) {
      float tmax = fmaxf(s0[0], s1[0]);
#pragma unroll
      for (int i = 1; i < 16; ++i) tmax = fmaxf(tmax, fmaxf(s0[i], s1[i]));
      tmax = swap_max(tmax);
      const float d = force ? tmax : fmaxf(tmax, 0.f);
      m += d;
      if constexpr (USE_LACC) {
#pragma unroll
        for (int i = 0; i < 16; ++i) negm[i] = -m;
      }
      if (!force) {
        const float alpha = __builtin_amdgcn_exp2f(-d);
        if constexpr (USE_LACC) {
#pragma unroll
          for (int i = 0; i < 16; ++i) Lacc[i] *= alpha;
        } else lsum *= alpha;
#pragma unroll
        for (int o = 0; o < NO; ++o)
#pragma unroll
          for (int i = 0; i < 16; ++i) O[o][i] *= alpha;
      }
#pragma unroll
      for (int i = 0; i < 16; ++i) { s0[i] -= d; s1[i] -= d; }
    }
#pragma unroll
    for (int i = 0; i < 16; ++i) { s0[i] = __builtin_amdgcn_exp2f(s0[i]); s1[i] = __builtin_amdgcn_exp2f(s1[i]); if constexpr (!USE_LACC) lsum += s0[i] + s1[i]; }
    const char* vb = lds + VBASE + cur * VBUF + l31 * VST + h * 8;
#pragma unroll
    for (int mt = 0; mt < 2; ++mt)
#pragma unroll
      for (int s2 = 0; s2 < 2; ++s2) {
        const f32x16& sv = mt == 0 ? s0 : s1;
        unsigned pw[4];
#pragma unroll
        for (int j = 0; j < 4; ++j) pw[j] = pack2(sv[8 * s2 + 2 * j], sv[8 * s2 + 2 * j + 1]);
        bf16x8 pf = __builtin_bit_cast(bf16x8, make_uint4(pw[0], pw[1], pw[2], pw[3]));
        const int ko = (32 * mt + 16 * s2) * 2;
        if constexpr (USE_LACC) Lacc = MFMA(ones, pf, Lacc);
#pragma unroll
        for (int o = 0; o < NO; ++o) {
          s16x4 lo = *(const s16x4*)(vb + o * 32 * VST + ko), hi = *(const s16x4*)(vb + o * 32 * VST + ko + 16);
          bf16x8 vf = __builtin_shufflevector(lo, hi, 0, 1, 2, 3, 4, 5, 6, 7);
          O[o] = MFMA(vf, pf, O[o]);
        }
      }
    if (more) LSTORE(cur ^ 1);
    __syncthreads();
  }
  if constexpr (USE_LACC) l = Lacc[0];
  else l = l + swap_sum(lsum);
}

template <int NS>
DI void load_q(bf16x8 (&qf)[NS], const bf16_t* __restrict__ qptr, int h) {
#pragma unroll
  for (int s = 0; s < NS; ++s) qf[s] = *(const bf16x8*)(qptr + 16 * s + 8 * h);
}
template <int NO>
DI void store_o(const f32x16 (&O)[NO], bf16_t* __restrict__ d, int h) {
#pragma unroll
  for (int o = 0; o < NO; ++o)
#pragma unroll
    for (int g = 0; g < 4; ++g) {
      uint2 w; w.x = pack2(O[o][4 * g], O[o][4 * g + 1]); w.y = pack2(O[o][4 * g + 2], O[o][4 * g + 3]);
      *(uint2*)(d + o * 32 + 8 * g + 4 * h) = w;
    }
}

DI void attn_phase(const Ctx cx0, const Params& p, int l, int slot, char* lds) {
  const int xcd = cx0.bid & 7;
  int* ctr = (int*)(p.ws + OFF_CTR) + slot * 8 + xcd;
  int* sh_item = (int*)(lds + LDS_MISC + 1024);
  const int NITEMS = (l == 0) ? 224 + 7 : 224;
  const float lam_init = 0.8f - 0.6f * __expf(-0.3f * (float)l);
  for (;;) {
    Ctx cx = cx0;
    asm volatile("" : "+v"(cx.tid));
    const int tid = cx.tid, lane = tid & 63, wave = tid >> 6, l31 = lane & 31, h = lane >> 5;
    if (tid == 0) *sh_item = atomicAdd(ctr, 1);
    __syncthreads();
    const int item = *sh_item;
    __syncthreads();
    if (item >= NITEMS) break;
    int br, b, head, qt; bool isctx = false;
    if (item < 32) { br = 0; b = xcd >> 2; head = xcd & 3; qt = item; }
    else if (item < 224) { int i = item - 32; br = 1 + (i >> 6); i &= 63; const int g = xcd + 8 * (i >> 5); b = g >> 3; head = g & 7; qt = i & 31; }
    else {
      isctx = true; qt = 0; int i = xcd * 7 + (item - 224);
      if (i < 8) { br = 0; b = i >> 2; head = i & 3; }
      else { i -= 8; br = 1 + (i >> 4); i &= 15; b = i >> 3; head = i & 7; }
    }
    const int r0 = b * RB + (isctx ? 0 : NCTX + qt * 256);
    const int rq = r0 + wave * 32 + l31;
    const int nka = isctx ? 4 : 132;
    if (br == 0) {
      const float* lv = p.diff_lambda + l * 256;
      float d1 = lv[lane] * lv[64 + lane], d2 = lv[128 + lane] * lv[192 + lane];
      d1 = wave_sum(d1); d2 = wave_sum(d2);
      const float lam = __expf(d1) - __expf(d2) + lam_init;
      const bf16_t* VT = (const bf16_t*)(p.ws + OFF_VA) + (size_t)(b * 4 + head) * 128 * RB;
      f32x16 O1[4];
#pragma unroll
      for (int o = 0; o < 4; ++o)
#pragma unroll
        for (int i = 0; i < 16; ++i) O1[o][i] = 0.f;
      float m1 = -100.f, l1 = 0.f, m2 = -100.f, l2 = 0.f;
      bf16_t* slot = (bf16_t*)(p.ws + OFF_QA) + (size_t)rq * 512 + head * 128;
      bf16x8 qa[4], qb[4];
      load_q<4>(qa, slot, h); load_q<4>(qb, slot + 64, h);
      attn_core<64, 128, false>(cx, qa, (const bf16_t*)(p.ws + OFF_KA) + (size_t)b * RB * 512 + (2 * head) * 64, 512, VT, nka, 0, 0, 0, m1, l1, O1, lds);
      const float i1 = 1.f / l1;
#pragma unroll
      for (int o = 0; o < 4; ++o)
#pragma unroll
        for (int i = 0; i < 16; ++i) O1[o][i] *= i1;
      store_o<4>(O1, slot, h);
#pragma unroll
      for (int o = 0; o < 4; ++o)
#pragma unroll
        for (int i = 0; i < 16; ++i) O1[o][i] = 0.f;
      attn_core<64, 128, false>(cx, qb, (const bf16_t*)(p.ws + OFF_KA) + (size_t)b * RB * 512 + (2 * head + 1) * 64, 512, VT, nka, 0, 0, 0, m2, l2, O1, lds);
      const float i2 = lam / l2;
      float ss = 0.f;
#pragma unroll
      for (int o = 0; o < 4; ++o)
#pragma unroll
        for (int g = 0; g < 4; ++g) {
          uint2 w = *(const uint2*)(slot + o * 32 + 8 * g + 4 * h);
          float a0 = __uint_as_float(w.x << 16) - O1[o][4 * g] * i2, a1 = __uint_as_float(w.x & 0xffff0000u) - O1[o][4 * g + 1] * i2;
          float a2 = __uint_as_float(w.y << 16) - O1[o][4 * g + 2] * i2, a3 = __uint_as_float(w.y & 0xffff0000u) - O1[o][4 * g + 3] * i2;
          O1[o][4 * g] = a0; O1[o][4 * g + 1] = a1; O1[o][4 * g + 2] = a2; O1[o][4 * g + 3] = a3;
          ss += a0 * a0 + a1 * a1 + a2 * a2 + a3 * a3;
        }
      ss = swap_sum(ss);
      const float rstd = rsqrtf(ss * (1.f / 128.f) + EPS) * (1.f - lam_init);
      const float* sg = p.diff_subln + l * 128;
#pragma unroll
      for (int o = 0; o < 4; ++o)
#pragma unroll
        for (int i = 0; i < 16; ++i) O1[o][i] *= rstd * sg[o * 32 + 8 * (i >> 2) + 4 * h + (i & 3)];
      store_o<4>(O1, (bf16_t*)(p.ws + OFF_QA) + (size_t)rq * 512 + head * 128, h);
    } else if (br == 1) {
      f32x16 O[2];
#pragma unroll
      for (int o = 0; o < 2; ++o)
#pragma unroll
        for (int i = 0; i < 16; ++i) O[o][i] = 0.f;
      float m = -100.f, ls = 0.f;
      bf16x8 qf[6]; load_q<6>(qf, (const bf16_t*)(p.ws + OFF_QB) + (size_t)rq * 768 + head * 96, h);
      attn_core<96, 64, false>(cx, qf,
                               (const bf16_t*)(p.ws + OFF_KB) + (size_t)b * RB * 768 + head * 96, 768,
                               (const bf16_t*)(p.ws + OFF_VB) + (size_t)(b * 8 + head) * 64 * RB, nka, 0, 0, 0, m, ls, O, lds);
      const float inv = 1.f / ls;
#pragma unroll
      for (int o = 0; o < 2; ++o)
#pragma unroll
        for (int i = 0; i < 16; ++i) O[o][i] *= inv;
      store_o<2>(O, (bf16_t*)(p.ws + OFF_OB) + (size_t)rq * 512 + head * 64, h);
    } else if (br == 2) {
      f32x16 O[2];
#pragma unroll
      for (int o = 0; o < 2; ++o)
#pragma unroll
        for (int i = 0; i < 16; ++i) O[o][i] = 0.f;
      float m = -100.f, ls = 0.f;
      const int kvh = head >> 2;
      bf16x8 qf[4]; load_q<4>(qf, (const bf16_t*)(p.ws + OFF_QC) + (size_t)rq * 512 + head * 64, h);
      attn_core<64, 64, false>(cx, qf,
                               (const bf16_t*)(p.ws + OFF_KC) + (size_t)b * RB * 128 + kvh * 64, 128,
                               (const bf16_t*)(p.ws + OFF_VC) + (size_t)(b * 2 + kvh) * 64 * RB, nka, 0, 0, 0, m, ls, O, lds);
      const float inv = 1.f / ls;
#pragma unroll
      for (int o = 0; o < 2; ++o)
#pragma unroll
        for (int i = 0; i < 16; ++i) O[o][i] *= inv;
      store_o<2>(O, (bf16_t*)(p.ws + OFF_QC) + (size_t)rq * 512 + head * 64, h);
    } else {
      f32x16 O[2];
#pragma unroll
      for (int o = 0; o < 2; ++o)
#pragma unroll
        for (int i = 0; i < 16; ++i) O[o][i] = 0.f;
      float m = p.swa_sink[l * 8 + head] * LOG2E, ls = 1.f;
      const int kvh = head >> 2;
      int tb0 = 0, nb = 0;
      if (!isctx) {
        int lo = max(2 * qt - 1, 0) * 128, hi = min(2 * qt + 3, 64) * 128;
        tb0 = 4 + (lo >> 6); nb = (hi - lo) >> 6;
      }
      bf16x8 qf[4]; load_q<4>(qf, (const bf16_t*)(p.ws + OFF_QD) + (size_t)rq * 512 + head * 64, h);
      attn_core<64, 64, true>(cx, qf,
                              (const bf16_t*)(p.ws + OFF_KD) + (size_t)b * RB * 128 + kvh * 64, 128,
                              (const bf16_t*)(p.ws + OFF_VD) + (size_t)(b * 2 + kvh) * 64 * RB, 4, tb0, nb, qt * 256 + wave * 32 + l31, m, ls, O, lds);
      const float inv = 1.f / ls;
#pragma unroll
      for (int o = 0; o < 2; ++o)
#pragma unroll
        for (int i = 0; i < 16; ++i) O[o][i] *= inv;
      store_o<2>(O, (bf16_t*)(p.ws + OFF_QD) + (size_t)rq * 512 + head * 64, h);
    }
  }
}

template <int MF>
DI void stage_tile(const Ctx cx, const f32x16 (&acc)[MF][2], float* U, int fbase_sub) {
  const int tid = cx.tid, lane = tid & 63, wave = tid >> 6, wn = wave & 3, l31 = lane & 31, h = lane >> 5;
#pragma unroll
  for (int ti = 0; ti < 2; ++ti)
#pragma unroll
    for (int fi = 0; fi < MF; ++fi)
#pragma unroll
      for (int g = 0; g < 4; ++g) {
        const int tokl = wn * 64 + ti * 32 + l31, fl = fbase_sub + fi * 32 + 8 * g + 4 * h;
        *(float4*)(U + tokl * 132 + fl) = make_float4(acc[fi][ti][4 * g], acc[fi][ti][4 * g + 1], acc[fi][ti][4 * g + 2], acc[fi][ti][4 * g + 3]);
      }
}
DI void merge_phase(const Ctx cx, const Params& p, int l, char* lds) {
  const int tid = cx.tid, wave = tid >> 6, wm = wave >> 2;
  const int fc = tid & 31, tr = tid >> 5;
  const bf16_t* H = (const bf16_t*)(p.ws + OFF_H);
  float* U = (float*)lds;
  const int ntt = l == 0 ? 66 : 64;
  XCD_ITEMS_BEGIN(ntt, 8)
    const int tt = tt_of(l, tti);
    float4 tot[16];
#pragma unroll
    for (int i = 0; i < 16; ++i) tot[i] = make_float4(0.f, 0.f, 0.f, 0.f);
#pragma unroll 1
    for (int k = 0; k < 4; ++k) {
      bf16_t* Mrow = (bf16_t*)(p.ws + OFF_M) + (size_t)(tt * 256 + tr) * 1024 + ft * 128 + 4 * fc;
      {
        f32x16 acc[2][2]; zero_acc<2>(acc);
        gemm_core<2>(cx, (const bf16_t*)(p.ws + OFF_WIN) + (size_t)(3840 + k * 1024 + ft * 128) * 1024, 1024, H, 1024, tt * 256, 0, R - 1, 1024, acc, lds);
        stage_tile<2>(cx, acc, U, wm * 64);
      }
      __syncthreads();
#pragma unroll
      for (int i = 0; i < 16; ++i) {
        const float4 u = *(const float4*)(U + (i * 16 + tr) * 132 + 4 * fc);
        uint2 g; g.x = pack2(sigmoid_f(u.x), sigmoid_f(u.y)); g.y = pack2(sigmoid_f(u.z), sigmoid_f(u.w));
        *(uint2*)(Mrow + (size_t)i * 16 * 1024) = g;
      }
      __syncthreads();
      {
        f32x16 acc[2][2]; zero_acc<2>(acc);
        const size_t xo = k == 0 ? OFF_QA : (k == 1 ? OFF_OB : (k == 2 ? OFF_QC : OFF_QD));
        gemm_core<2>(cx, (const bf16_t*)(p.ws + OFF_WBR) + (size_t)(k * 1024 + ft * 128) * 512, 512, (const bf16_t*)(p.ws + xo), 512, tt * 256, 0, R - 1, 512, acc, lds);
        stage_tile<2>(cx, acc, U, wm * 64);
      }
      __syncthreads();
#pragma unroll
      for (int i = 0; i < 16; ++i) {
        const float4 u = *(const float4*)(U + (i * 16 + tr) * 132 + 4 * fc);
        const uint2 g = *(const uint2*)(Mrow + (size_t)i * 16 * 1024);
        tot[i].x += __uint_as_float(g.x << 16) * u.x; tot[i].y += __uint_as_float(g.x & 0xffff0000u) * u.y;
        tot[i].z += __uint_as_float(g.y << 16) * u.z; tot[i].w += __uint_as_float(g.y & 0xffff0000u) * u.w;
      }
      __syncthreads();
    }
    bf16_t* M = (bf16_t*)(p.ws + OFF_M);
#pragma unroll
    for (int i = 0; i < 16; ++i) {
      uint2 o; o.x = pack2(tot[i].x, tot[i].y); o.y = pack2(tot[i].z, tot[i].w);
      *(uint2*)(M + (size_t)(tt * 256 + i * 16 + tr) * 1024 + ft * 128 + 4 * fc) = o;
    }
  XCD_ITEMS_END
}

template <int MF>
DI void resid_item(const Ctx cx, const Params& p, const float* modv, const bf16_t* W, int K, const bf16_t* X, bool from_inputs, int tt, int fbase, char* lds, int skip_epi) {
  constexpr int FH = MF == 4 ? 2 : 1, FW = MF == 4 ? 128 : 64 * MF;
  constexpr int LPR = FW / 4, RPP = 512 / LPR, NP = 256 / RPP;
  const int tid = cx.tid, wave = tid >> 6, wm = wave >> 2;
  const int fc = tid & (LPR - 1), tr = tid / LPR;
  float* U = (float*)lds;
  f32x16 acc[MF][2]; zero_acc<MF>(acc);
  gemm_core<MF>(cx, W + (size_t)fbase * K, K, X, K, tt * 256, 0, R - 1, K, acc, lds);
  if (skip_epi) { if (acc[0][0][0] == 12345.678f && acc[0][1][3] == 1.f) ((float*)(p.ws + OFF_CTR))[40] = 1.f; return; }
  const float* mv = modv + variant_of(tt * 256) * 6144;
#pragma unroll 1
  for (int fh = 0; fh < FH; ++fh) {
    if (MF == 4) { if (wm == fh) stage_tile<MF>(cx, acc, U, 0); }
    else stage_tile<MF>(cx, acc, U, wm * 32 * MF);
    __syncthreads();
    const int f = fbase + fh * 128 + 4 * fc;
    const float4 mm = *(const float4*)(mv + f);
    const float* xs0 = x_row_src(p, from_inputs, tt * 256) + (size_t)tr * 1024 + f;
    float* xd0 = x_row_dst(p, tt * 256) + (size_t)tr * 1024 + f;
    const float* up = U + tr * 132 + 4 * fc;
#pragma unroll 1
    for (int i4 = 0; i4 < NP / 4; ++i4) {
      float4 xo[4];
#pragma unroll
      for (int j = 0; j < 4; ++j) xo[j] = *(const float4*)(xs0 + (size_t)(i4 * 4 + j) * RPP * 1024);
#pragma unroll
      for (int j = 0; j < 4; ++j) {
        const float4 u = *(const float4*)(up + (i4 * 4 + j) * RPP * 132);
        float4 o = xo[j];
        o.x += mm.x * u.x; o.y += mm.y * u.y; o.z += mm.z * u.z; o.w += mm.w * u.w;
        { float* xq_ = xd0 + (size_t)(i4 * 4 + j) * RPP * 1024; __builtin_nontemporal_store(o.x, xq_); __builtin_nontemporal_store(o.y, xq_ + 1); __builtin_nontemporal_store(o.z, xq_ + 2); __builtin_nontemporal_store(o.w, xq_ + 3); }
      }
    }
    __syncthreads();
  }
}
DI void resid_gemm_phase(const Ctx cx, const Params& p, int l, const bf16_t* W, int K, const bf16_t* X, int midx, bool from_inputs, char* lds, int skip_epi = 0) {
  const float* modv = (const float*)(p.ws + OFF_MODV) + (size_t)l * 3 * 6144 + midx * 1024;
  XCD_ITEMS_BEGIN(64, 4)
    resid_item<4>(cx, p, modv, W, K, X, from_inputs, tt_of(1, tti), ft * 256, lds, skip_epi);
  XCD_ITEMS_END
  if (l == 0)
    for (int q = cx.bid; q < 32; q += (int)gridDim.x) resid_item<1>(cx, p, modv, W, K, X, from_inputs, (q >> 4) ? 33 : 0, (q & 15) * 64, lds, skip_epi);
}

DI void ffn_up_phase(const Ctx cx, const Params& p, int l, char* lds) {
  const int tid = cx.tid, lane = tid & 63, wave = tid >> 6, wm = wave >> 2, wn = wave & 3, l31 = lane & 31, h = lane >> 5;
  const bf16_t* H = (const bf16_t*)(p.ws + OFF_H);
  const bf16_t* W = (const bf16_t*)(p.ws + OFF_WUP);
  bf16_t* ACT = (bf16_t*)(p.ws + OFF_ACT);
  float* U = (float*)lds;
  const int ntk = l == 0 ? 68 : 66;
  const float* cw = p.ffn_conv_w + (size_t)l * 3 * 5632;
  const float* cb = p.ffn_conv_b + (size_t)l * 5632;
  XCD_ITEMS_BEGIN(ntk, 22)
    const int tk = tti;
    int rs, len, ti_; bool isctx = false;
    if (l == 0) { int b = tk / 34, i = tk % 34; if (i < 1) { rs = b * RB; len = NCTX; ti_ = 0; isctx = true; } else { rs = b * RB + NCTX; len = NMAIN; ti_ = i - 1; } }
    else { int b = tk / 33; rs = b * RB + NCTX; len = NMAIN; ti_ = tk % 33; }
    const int q0 = isctx ? 0 : 254 * ti_ - 1;
    f32x16 acc[4][2]; zero_acc<4>(acc);
    gemm_core<4, true>(cx, W + (size_t)ft * 256 * 1024, 1024, H, 1024, rs + q0, rs, rs + len - 1, 1024, acc, lds);
#pragma unroll 1
    for (int fh = 0; fh < 2; ++fh) {
      if (wm == fh) {
#pragma unroll
        for (int ti = 0; ti < 2; ++ti)
#pragma unroll
          for (int fi = 0; fi < 4; ++fi)
#pragma unroll
            for (int g = 0; g < 4; ++g) {
              const int tokl = wn * 64 + ti * 32 + l31, fl = fi * 32 + 8 * g + 4 * h;
              *(float4*)(U + tokl * 132 + fl) = make_float4(acc[fi][ti][4 * g], acc[fi][ti][4 * g + 1], acc[fi][ti][4 * g + 2], acc[fi][ti][4 * g + 3]);
            }
      }
      __syncthreads();
      {
        const int j = tid & 63, c = tid >> 6;
        const int fv = ft * 128 + fh * 64 + j, fg = 2816 + fv;
        const float wv0 = cw[fv], wv1 = cw[5632 + fv], wv2 = cw[2 * 5632 + fv], bv = cb[fv];
        const float wg0 = cw[fg], wg1 = cw[5632 + fg], wg2 = cw[2 * 5632 + fg], bg = cb[fg];
        const int t0 = (isctx ? 0 : 1) + 32 * c, t1 = min(t0 + 32, isctx ? 256 : 255);
        float pv = (q0 + t0 - 1 >= 0) ? U[(t0 - 1) * 132 + j] : 0.f, pg = (q0 + t0 - 1 >= 0) ? U[(t0 - 1) * 132 + 64 + j] : 0.f;
        float cv = U[t0 * 132 + j], cgt = U[t0 * 132 + 64 + j];
        for (int t = t0; t < t1; ++t) {
          const int q = q0 + t;
          if (q >= len) break;
          float nv = (q + 1 < len) ? U[(t + 1) * 132 + j] : 0.f, ng = (q + 1 < len) ? U[(t + 1) * 132 + 64 + j] : 0.f;
          float val = wv0 * pv + wv1 * cv + wv2 * nv + bv;
          float gat = wg0 * pg + wg1 * cgt + wg2 * ng + bg;
          float a = silu_f(gat) * val;
          __builtin_nontemporal_store((bf16_t)(pack2(a, 0.f) & 0xffff), &ACT[(size_t)(rs + q) * 2816 + fv]);
          pv = cv; pg = cgt; cv = nv; cgt = ng;
        }
      }
      __syncthreads();
    }
  XCD_ITEMS_END
}

DI void final_phase(const Ctx cx, const Params& p) {
  const int tid = cx.tid, lane = tid & 63, wave = tid >> 6;
  for (int r = cx.bid * 8 + wave; r < 2 * NMAIN; r += gridDim.x * 8) {
    float* xr = p.out + (size_t)r * DM;
    float4 xv[4]; float ss = 0.f;
#pragma unroll
    for (int i = 0; i < 4; ++i) { xv[i] = *(const float4*)(xr + i * 256 + lane * 4); ss += xv[i].x * xv[i].x + xv[i].y * xv[i].y + xv[i].z * xv[i].z + xv[i].w * xv[i].w; }
    ss = wave_sum(ss);
    const float rstd = rsqrtf(ss * (1.f / 1024.f) + EPS);
#pragma unroll
    for (int i = 0; i < 4; ++i) {
      float4 g = *(const float4*)(p.final_norm + i * 256 + lane * 4);
      float4 o = make_float4(xv[i].x * rstd * g.x, xv[i].y * rstd * g.y, xv[i].z * rstd * g.z, xv[i].w * rstd * g.w);
      *(float4*)(xr + i * 256 + lane * 4) = o;
    }
  }
}


#define XB_TMO      128
#define XB_XCNT(j)  (256  + 64 * (j))
#define XB_XSUB(j)  (1280 + 64 * (j))
#define XB_XGEN(j)  (2304 + 64 * (j))
#define XB_TOP      3328
#define XB_TOPGEN   3392
#define XCD_BAR_WORDS 3456
#define XB_SPIN_CAP (1u << 20)
#define LAS __attribute__((address_space(3)))
DI unsigned xb_ld(unsigned* p)              { return __hip_atomic_load(p, __ATOMIC_RELAXED, __HIP_MEMORY_SCOPE_AGENT); }
DI unsigned xb_add(unsigned* p, unsigned v) { return __hip_atomic_fetch_add(p, v, __ATOMIC_RELAXED, __HIP_MEMORY_SCOPE_AGENT); }
DI unsigned xb_xcc_id() { return (unsigned)__builtin_amdgcn_s_getreg((3 << 11) | 20) & 0xFu; }
#define XB_SPIN(cond, bar) do { unsigned _sp = 0; while (cond) { __builtin_amdgcn_s_sleep(1); \
    if ((++_sp & 255u) == 0u) { if (xb_ld(&(bar)[XB_TMO])) break; if (_sp > XB_SPIN_CAP) { atomicAdd(&(bar)[XB_TMO], 1u); break; } } } } while (0)
struct XcdBarrier { unsigned* bar; unsigned x; volatile LAS unsigned* st; };
DI XcdBarrier xcd_barrier_post(unsigned* bar, volatile LAS unsigned* st) {
  XcdBarrier b; b.bar = bar; b.x = xb_xcc_id(); b.st = st;
  if (threadIdx.x == 0) (void)xb_add(&bar[XB_XCNT(b.x)], 1u);
  return b;
}
DI void xcd_barrier_complete(unsigned* bar, unsigned x, unsigned& nloc, unsigned& nx) {
  const unsigned G = gridDim.x * gridDim.y * gridDim.z;
  unsigned sum, cnt, mine, sp = 0u;
  for (;;) {
    sum = 0u; cnt = 0u; mine = 0u;
#pragma unroll
    for (unsigned j = 0; j < 16; ++j) { const unsigned c = xb_ld(&bar[XB_XCNT(j)]); sum += c; cnt += (c > 0u) ? 1u : 0u; mine = (j == x) ? c : mine; }
    if (sum == G) break;
    __builtin_amdgcn_s_sleep(1);
    if ((++sp & 255u) == 0u) { if (xb_ld(&bar[XB_TMO])) break; if (sp > XB_SPIN_CAP) { atomicAdd(&bar[XB_TMO], 1u); break; } }
  }
  nloc = mine > 0u ? mine : 1u; nx = cnt > 0u ? cnt : 1u;
}
DI void xcd_barrier(const XcdBarrier& b, const int tid) {
  asm volatile("s_waitcnt vmcnt(0)" ::: "memory");
  __syncthreads();
  if (tid == 0) {
    unsigned* bar = b.bar;
    __builtin_amdgcn_s_waitcnt(0);
    unsigned nloc = b.st[0], nx = b.st[1];
    if (nloc == 0u) { xcd_barrier_complete(bar, b.x, nloc, nx); b.st[0] = nloc; b.st[1] = nx; }
    const unsigned old = xb_add(&bar[XB_XSUB(b.x)], 1u);
    const unsigned gen = old / nloc;
    if (old + 1u == (gen + 1u) * nloc) {
      __builtin_amdgcn_fence(__ATOMIC_RELEASE, "agent");
      asm volatile("s_waitcnt vmcnt(0)" ::: "memory");
      const unsigned og = xb_add(&bar[XB_TOP], 1u);
      const unsigned tg = og / nx;
      if (og + 1u == (tg + 1u) * nx) xb_add(&bar[XB_TOPGEN], 1u);
      else XB_SPIN(xb_ld(&bar[XB_TOPGEN]) == tg, bar);
      __builtin_amdgcn_fence(__ATOMIC_ACQUIRE, "agent");
      xb_add(&bar[XB_XGEN(b.x)], 1u);
      asm volatile("s_waitcnt vmcnt(0)" ::: "memory");
    } else {
      XB_SPIN(xb_ld(&bar[XB_XGEN(b.x)]) == gen, bar);
      __builtin_amdgcn_fence(__ATOMIC_ACQUIRE, "agent");
      asm volatile("s_waitcnt vmcnt(0)" ::: "memory");
    }
  }
  __syncthreads();
}

constexpr int NPHASES = 20;
DI void run_phase(const Ctx cx, const Params& p, int ph, char* lds, int slot_add = 0) {
  if (ph == 0) { prep0(cx, p, lds); return; }
  if (ph == NPHASES - 1) { final_phase(cx, p); return; }
  const int l = (ph - 1) / 9, s = (ph - 1) % 9;
  switch (s) {
    case 0: if (l == 1) convert_mix(cx, p, 1, lds); norm_phase(cx, p, l, 0, l == 0, l == 0, false, lds); break;
    case 1: gemm_in_phase(cx, p, l, lds, slot_add >= 100); break;
    case 2: gemm_mla_phase(cx, p, lds); break;
    case 3: attn_phase(cx, p, l, l + slot_add, lds); break;
    case 4: merge_phase(cx, p, l, lds); break;
    case 5: resid_gemm_phase(cx, p, l, (const bf16_t*)(p.ws + OFF_WOUT), 1024, (const bf16_t*)(p.ws + OFF_M), 2, l == 0, lds, slot_add >= 100); break;
    case 6: convert_ffn(cx, p, l, lds); norm_phase(cx, p, l, 1, false, false, l == 1, lds); break;
    case 7: ffn_up_phase(cx, p, l, lds); break;
    case 8: resid_gemm_phase(cx, p, l, (const bf16_t*)(p.ws + OFF_WDN), 2816, (const bf16_t*)(p.ws + OFF_ACT), 5, false, lds); break;
  }
}

__global__ void __launch_bounds__(512, 2) mega(Params p, int ph_lo, int ph_hi) {
  extern __shared__ __attribute__((aligned(16))) char lds[];
  __shared__ uint4 xb_words;
  if (threadIdx.x == 0) xb_words = make_uint4(0u, 0u, 0u, 0u);
  __syncthreads();
  const XcdBarrier xb = xcd_barrier_post((unsigned*)(p.ws + OFF_BAR), (volatile LAS unsigned*)&xb_words);
#define GRID_SYNC(PH) do { if ((PH) == 0) cg::this_grid().sync(); else xcd_barrier(xb, cx.tid); } while (0)
#define STEP(PH) if (ph_lo <= (PH) && (PH) < ph_hi) { \
    Ctx cx; cx.tid = __builtin_amdgcn_workitem_id_x(); cx.bid = __builtin_amdgcn_workgroup_id_x(); \
    asm volatile("" : "+v"(cx.tid)); asm volatile("" : "+v"(cx.bid)); cx.bid = __builtin_amdgcn_readfirstlane(cx.bid); \
    Params q = p; int zoff = 0; asm volatile("" : "+v"(zoff)); zoff = __builtin_amdgcn_readfirstlane(zoff); q.ws = p.ws + (size_t)(unsigned)zoff; \
    run_phase(cx, q, (PH), lds); \
    if ((PH) + 1 < ph_hi) GRID_SYNC(PH); }
#define RSTEP(PH, SA) { Ctx cx; cx.tid = __builtin_amdgcn_workitem_id_x(); cx.bid = __builtin_amdgcn_workgroup_id_x(); \
    asm volatile("" : "+v"(cx.tid)); asm volatile("" : "+v"(cx.bid)); cx.bid = __builtin_amdgcn_readfirstlane(cx.bid); \
    Params q = p; int zoff = 0; asm volatile("" : "+v"(zoff)); zoff = __builtin_amdgcn_readfirstlane(zoff); q.ws = p.ws + (size_t)(unsigned)zoff; \
    int sa_ = (SA); asm volatile("" : "+v"(sa_)); sa_ = __builtin_amdgcn_readfirstlane(sa_); run_phase(cx, q, (PH), lds, sa_); xcd_barrier(xb, cx.tid); }
#if PROBE == 0
  STEP(0) STEP(1) STEP(2) STEP(3) STEP(4) STEP(5) STEP(6) STEP(7) STEP(8) STEP(9)
#elif PROBE == 1
  STEP(0) STEP(1) STEP(2) RSTEP(2, 0) STEP(3) STEP(4) STEP(5) STEP(6) STEP(7) STEP(8) STEP(9)
#elif PROBE == 2
  STEP(0) STEP(1) STEP(2) STEP(3) STEP(4) RSTEP(2, 0) RSTEP(3, 0) RSTEP(4, 2) STEP(5) STEP(6) STEP(7) STEP(8) STEP(9)
#elif PROBE == 3
  STEP(0) STEP(1) STEP(2) STEP(3) STEP(4) STEP(5) RSTEP(5, 0) STEP(6) STEP(7) STEP(8) STEP(9)
#elif PROBE == 7
  STEP(0) RSTEP(0, 0) STEP(1) STEP(2) STEP(3) STEP(4) STEP(5) STEP(6) STEP(7) STEP(8) STEP(9)
#elif PROBE == 8
  STEP(0) STEP(1) STEP(2) STEP(3) STEP(4) STEP(5) STEP(6) STEP(7) RSTEP(7, 0) STEP(8) STEP(9)
#elif PROBE == 9
  STEP(0) STEP(1) RSTEP(1, 0) STEP(2) STEP(3) RSTEP(3, 0) STEP(4) STEP(5) STEP(6) STEP(7) STEP(8) STEP(9)
#elif PROBE == 10
  STEP(0) STEP(1) STEP(2) RSTEP(2, 100) STEP(3) STEP(4) STEP(5) STEP(6) RSTEP(6, 100) STEP(7) STEP(8) STEP(9)
#elif PROBE == 5
  STEP(0) STEP(1) STEP(2) STEP(3) STEP(4) STEP(5) STEP(6) RSTEP(6, 0) STEP(7) STEP(8) STEP(9)
#elif PROBE == 6
  STEP(0) STEP(1) STEP(2) STEP(3) STEP(4) STEP(5) STEP(6) STEP(7) STEP(8) RSTEP(8, 0) STEP(9)
#elif PROBE == 4
  STEP(0) RSTEP(0, 0) STEP(1) RSTEP(1, 0) STEP(2) STEP(3) RSTEP(3, 0) STEP(4) STEP(5) STEP(6) STEP(7) RSTEP(7, 0) STEP(8) STEP(9)
#endif
  STEP(10) STEP(11) STEP(12) STEP(13) STEP(14) STEP(15) STEP(16) STEP(17) STEP(18) STEP(19)
}

extern "C" void kernel_launch(void* const* d_in, const int* in_sizes, int n_in, void* d_out, int out_size, void* d_ws, size_t ws_size, hipStream_t stream) {
  static int grid_blocks = 0;
  if (!grid_blocks) {
    hipFuncSetAttribute((const void*)mega, hipFuncAttributeMaxDynamicSharedMemorySize, LDS_BYTES);
    int dev = 0, cus = 0, per_cu = 0;
    hipGetDevice(&dev);
    hipDeviceGetAttribute(&cus, hipDeviceAttributeMultiprocessorCount, dev);
    hipOccupancyMaxActiveBlocksPerMultiprocessor(&per_cu, mega, NTH, LDS_BYTES);
    if (per_cu > 1) per_cu = 1;
    if (per_cu < 1) per_cu = 1;
    grid_blocks = cus * per_cu;
    if (ws_size < WS_NEED) fprintf(stderr, "workspace too small: %zu < %zu\n", ws_size, (size_t)WS_NEED);
  }
  Params p{};
  const float* const* in = (const float* const*)d_in;
  p.x = in[0]; p.c = in[1]; p.ctx = in[2]; p.c_ctx = in[3]; p.w_mod = in[4]; p.b_mod = in[5]; p.w_in = in[6]; p.diff_lambda = in[7];
  p.diff_subln = in[8]; p.mla_q_norm = in[9]; p.mla_kv_norm = in[10]; p.mla_w_uq = in[11]; p.mla_w_ukv = in[12]; p.gqa_q_norm = in[13];
  p.gqa_k_norm = in[14]; p.swa_sink = in[15]; p.w_branch = in[16]; p.w_out = in[17]; p.ffn_w_up = in[18]; p.ffn_conv_w = in[19];
  p.ffn_conv_b = in[20]; p.ffn_w_down = in[21]; p.final_norm = in[22];
  p.out = (float*)d_out; p.ws = (char*)d_ws;
#if MK_COOP
  hipMemsetAsync((char*)d_ws + OFF_BAR, 0, XCD_BAR_WORDS * sizeof(unsigned), stream);
  int lo = 0, hi = NPHASES;
  void* args[] = {&p, &lo, &hi};
  hipError_t e = hipLaunchCooperativeKernel((const void*)mega, dim3(grid_blocks), dim3(NTH), args, LDS_BYTES, stream);
  if (e != hipSuccess) fprintf(stderr, "cooperative launch failed: %s (grid %d)\n", hipGetErrorString(e), grid_blocks);
#else
  for (int ph = 0; ph < NPHASES; ++ph) hipLaunchKernelGGL(mega, dim3(grid_blocks), dim3(NTH), LDS_BYTES, stream, p, ph, ph + 1);
#endif
}
```
